# Optimizing an MI355X kernel written in HIP

```python
import jax, jax.numpy as jnp
from jax import lax
import numpy as np

D_MODEL = 1024
BATCH = 8
SEQ = 8192
DEPTH = 1

HEAD_DIM = 64
NSA_HEADS = 8
NSA_KV_HEADS = 2
NSA_GROUP = NSA_HEADS // NSA_KV_HEADS
NSA_WIDTH = NSA_HEADS * HEAD_DIM
KV_WIDTH = NSA_KV_HEADS * HEAD_DIM
N_BRANCH = 3
CMP_LEN = 32
CMP_STRIDE = 16
SEL_BLOCK = 64
SEL_TOPK = 16
WINDOW = 512
FORCE_SCORE = 1e4
POOL_WINDOWS = (2, 4, 8, 16)
POOL_GROUPS = 4
POOL_GROUP_DIM = 64
POOL_WIDTH = POOL_GROUPS * POOL_GROUP_DIM
MEM_HEADS = 4
MEM_LEN = 256
MEM_WIDTH = MEM_HEADS * HEAD_DIM
MIX_WIDTH = NSA_WIDTH + POOL_WIDTH + MEM_WIDTH
ROPE_THETA = 500000.0
ROPE_DIM = HEAD_DIM // 4
EPS = 1e-6
Q_BLOCK = 32
IN_SPLITS = (NSA_WIDTH, 6 * KV_WIDTH, NSA_HEADS * N_BRANCH, NSA_WIDTH,
             POOL_WIDTH, POOL_WIDTH, MEM_WIDTH, MEM_WIDTH)
IN_WIDTH = sum(IN_SPLITS)

kernel_name = "hymba_nsa_pool_memory_layer"


def rms_norm(x, g):
    x32 = x.astype(jnp.float32)
    y = x32 * lax.rsqrt(jnp.mean(x32 * x32, axis=-1, keepdims=True) + EPS)
    return (y * g.astype(jnp.float32)).astype(x.dtype)


def partial_rope(x, pos):
    half = ROPE_DIM // 2
    inv_freq = ROPE_THETA ** (-jnp.arange(half, dtype=jnp.float32) / half)
    ang = pos.astype(jnp.float32)[:, None, :, None] * inv_freq
    cos, sin = jnp.cos(ang), jnp.sin(ang)
    x32 = x.astype(jnp.float32)
    x1, x2 = x32[..., :half], x32[..., half:ROPE_DIM]
    out = jnp.concatenate([x1 * cos - x2 * sin, x1 * sin + x2 * cos, x32[..., ROPE_DIM:]], axis=-1)
    return out.astype(x.dtype)


def masked_softmax(s, mask):
    s = jnp.where(mask, s, -jnp.inf)
    m = jnp.max(s, axis=-1, keepdims=True)
    m = jnp.where(jnp.isfinite(m), m, 0.0)
    e = jnp.where(mask, jnp.exp(s - m), 0.0)
    return e / jnp.maximum(jnp.sum(e, axis=-1, keepdims=True), jnp.finfo(jnp.float32).tiny)


def compress_blocks(kv_raw, pos_emb, w1, w2):
    S = kv_raw.shape[1]
    nc = (S - CMP_LEN) // CMP_STRIDE + 1
    idx = np.arange(nc)[:, None] * CMP_STRIDE + np.arange(CMP_LEN)[None, :]
    blocks = kv_raw[:, idx] + pos_emb[None, None, :, None, :]
    hid = jax.nn.gelu(jnp.einsum('bnlgd,lde->bgne', blocks, w1))
    return jnp.einsum('bgne,ef->bgnf', hid, w2)


def cmp_to_sel_map(nc, ns):
    c0 = np.arange(nc) * CMP_STRIDE
    c1 = c0 + CMP_LEN
    s0 = np.arange(ns) * SEL_BLOCK
    s1 = s0 + SEL_BLOCK
    ov = np.clip(np.minimum(c1[:, None], s1[None, :]) - np.maximum(c0[:, None], s0[None, :]), 0, None)
    return (ov / CMP_LEN).astype(np.float32)


def nsa_mixer(q_n, kv_n, gate_n, positions, g_q_nsa, g_k_cmp, g_k_slc, g_k_win,
              cmp_pos_k, w_cmp_k1, w_cmp_k2, cmp_pos_v, w_cmp_v1, w_cmp_v2):
    B, S, _ = q_n.shape
    G, R, hd = NSA_KV_HEADS, NSA_GROUP, HEAD_DIM
    dt = q_n.dtype
    scale = HEAD_DIM ** -0.5
    nc = (S - CMP_LEN) // CMP_STRIDE + 1
    ns = S // SEL_BLOCK
    top_n = min(SEL_TOPK, ns)

    q = q_n.reshape(B, S, NSA_HEADS, hd).transpose(0, 2, 1, 3)
    q = partial_rope(rms_norm(q, g_q_nsa), positions)
    kv = kv_n.reshape(B, S, 6, G, hd)
    kc_raw, vc_raw = kv[:, :, 0], kv[:, :, 1]
    k_s, v_s = kv[:, :, 2].transpose(0, 2, 1, 3), kv[:, :, 3].transpose(0, 2, 1, 3)
    k_w, v_w = kv[:, :, 4].transpose(0, 2, 1, 3), kv[:, :, 5].transpose(0, 2, 1, 3)

    end_idx = np.arange(nc) * CMP_STRIDE + CMP_LEN - 1
    k_c = compress_blocks(kc_raw, cmp_pos_k, w_cmp_k1, w_cmp_k2)
    k_c = partial_rope(rms_norm(k_c, g_k_cmp), positions[:, end_idx])
    v_c = compress_blocks(vc_raw, cmp_pos_v, w_cmp_v1, w_cmp_v2)

    k_s = partial_rope(rms_norm(k_s, g_k_slc), positions)
    kb = k_s.reshape(B, G, ns, SEL_BLOCK, hd)
    vb = v_s.reshape(B, G, ns, SEL_BLOCK, hd)

    k_w = partial_rope(rms_norm(k_w, g_k_win), positions)
    pad = ((0, 0), (0, 0), (WINDOW, 0), (0, 0))
    kw_pad, vw_pad = jnp.pad(k_w, pad), jnp.pad(v_w, pad)

    gates = jax.nn.sigmoid(gate_n.astype(jnp.float32)).reshape(B, S, NSA_HEADS, N_BRANCH)
    gates = gates.transpose(0, 2, 1, 3).astype(dt)

    sel_map = jnp.asarray(cmp_to_sel_map(nc, ns))
    end_idx_j = jnp.asarray(end_idx)
    blk = jnp.arange(ns)
    b_ix = jnp.arange(B)[:, None, None, None]
    g_ix = jnp.arange(G)[None, :, None, None]

    def query_block(i):
        start = i * Q_BLOCK
        t = start + jnp.arange(Q_BLOCK)
        qb = lax.dynamic_slice_in_dim(q, start, Q_BLOCK, axis=2).reshape(B, G, R, Q_BLOCK, hd)

        s_c = jnp.einsum('bgrqd,bgnd->bgrqn', qb, k_c, preferred_element_type=jnp.float32) * scale
        c_mask = end_idx_j[None, :] <= t[:, None]
        p_c = masked_softmax(s_c, c_mask)
        o_c = jnp.einsum('bgrqn,bgnd->bgrqd', p_c.astype(dt), v_c)

        imp = jnp.einsum('bgqn,nj->bgqj', jnp.sum(p_c, axis=2), sel_map)
        cur = t // SEL_BLOCK
        forced = (blk[None, :] == 0) | (blk[None, :] == cur[:, None]) | (blk[None, :] == cur[:, None] - 1)
        valid = blk[None, :] <= cur[:, None]
        imp = jnp.where(forced, FORCE_SCORE, jnp.where(valid, imp, -1.0))
        _, sel = lax.top_k(imp, top_n)
        ks_g = kb[b_ix, g_ix, sel]
        vs_g = vb[b_ix, g_ix, sel]
        s_pos = (sel[..., None] * SEL_BLOCK + jnp.arange(SEL_BLOCK)).reshape(B, G, Q_BLOCK, top_n * SEL_BLOCK)
        s_mask = (s_pos <= t[None, None, :, None])[:, :, None]
        s_s = jnp.einsum('bgrqd,bgqkld->bgrqkl', qb, ks_g, preferred_element_type=jnp.float32)
        s_s = s_s.reshape(B, G, R, Q_BLOCK, top_n * SEL_BLOCK) * scale
        p_s = masked_softmax(s_s, s_mask).reshape(B, G, R, Q_BLOCK, top_n, SEL_BLOCK)
        o_s = jnp.einsum('bgrqkl,bgqkld->bgrqd', p_s.astype(dt), vs_g)

        kw_blk = lax.dynamic_slice_in_dim(kw_pad, start, WINDOW + Q_BLOCK, axis=2)
        vw_blk = lax.dynamic_slice_in_dim(vw_pad, start, WINDOW + Q_BLOCK, axis=2)
        kpos = start - WINDOW + jnp.arange(WINDOW + Q_BLOCK)
        w_mask = (kpos[None, :] <= t[:, None]) & (kpos[None, :] > t[:, None] - WINDOW) & (kpos[None, :] >= 0)
        s_w = jnp.einsum('bgrqd,bgkd->bgrqk', qb, kw_blk, preferred_element_type=jnp.float32) * scale
        p_w = masked_softmax(s_w, w_mask)
        o_w = jnp.einsum('bgrqk,bgkd->bgrqd', p_w.astype(dt), vw_blk)

        gb = lax.dynamic_slice_in_dim(gates, start, Q_BLOCK, axis=2).reshape(B, G, R, Q_BLOCK, N_BRANCH)
        o = gb[..., 0:1] * o_c + gb[..., 1:2] * o_s + gb[..., 2:3] * o_w
        return o.reshape(B, NSA_HEADS, Q_BLOCK, hd)

    o_blocks = lax.map(query_block, jnp.arange(S // Q_BLOCK))
    return o_blocks.transpose(1, 0, 3, 2, 4).reshape(B, S, NSA_WIDTH)


def pool_mixer(v_p, w_pool, pool_scale):
    B, S, _ = v_p.shape
    v32 = v_p.reshape(B, S, POOL_GROUPS, POOL_GROUP_DIM).astype(jnp.float32)
    cs = jnp.cumsum(v32, axis=1)
    count_base = jnp.arange(1, S + 1, dtype=jnp.float32)
    pooled = []
    for g, w in enumerate(POOL_WINDOWS):
        c = cs[:, :, g]
        lower = jnp.pad(c[:, :S - w], ((0, 0), (w, 0), (0, 0)))
        cnt = jnp.minimum(count_base, float(w))[None, :, None]
        pooled.append((c - lower) / cnt - v32[:, :, g])
    pooled = jnp.stack(pooled, axis=2).astype(v_p.dtype)
    out = jnp.einsum('bsgc,gce->bsge', pooled, w_pool).reshape(B, S, POOL_WIDTH)
    return out * pool_scale


def memory_mixer(q_m, mem, g_mem, w_mem_kv, g_q_mem, g_k_mem):
    B, S, _ = q_m.shape
    M = mem.shape[1]
    scale = HEAD_DIM ** -0.5
    m_h = rms_norm(mem, g_mem)
    mkv = jnp.einsum('bmd,de->bme', m_h, w_mem_kv).reshape(B, M, 2, MEM_HEADS, HEAD_DIM)
    mk = rms_norm(mkv[:, :, 0], g_k_mem)
    mv = mkv[:, :, 1]
    mq = rms_norm(q_m.reshape(B, S, MEM_HEADS, HEAD_DIM), g_q_mem)
    s_m = jnp.einsum('bshd,bmhd->bhsm', mq, mk, preferred_element_type=jnp.float32) * scale
    p_m = jax.nn.softmax(s_m, axis=-1)
    return jnp.einsum('bhsm,bmhd->bshd', p_m.astype(q_m.dtype), mv).reshape(B, S, MEM_WIDTH)


def hybrid_layer(x, mem, positions, g_norm, w_in, g_q_nsa, g_k_cmp, g_k_slc, g_k_win,
                 cmp_pos_k, w_cmp_k1, w_cmp_k2, cmp_pos_v, w_cmp_v1, w_cmp_v2,
                 w_pool, pool_scale, g_mem, w_mem_kv, g_q_mem, g_k_mem, w_out):
    h = rms_norm(x, g_norm)
    proj = jnp.einsum('bsd,de->bse', h, w_in)
    split_at = np.cumsum(IN_SPLITS)[:-1].tolist()
    q_n, kv_n, gate_n, z_n, v_p, z_p, q_m, z_m = jnp.split(proj, split_at, axis=-1)
    o_nsa = nsa_mixer(q_n, kv_n, gate_n, positions, g_q_nsa, g_k_cmp, g_k_slc, g_k_win,
                      cmp_pos_k, w_cmp_k1, w_cmp_k2, cmp_pos_v, w_cmp_v1, w_cmp_v2)
    o_pool = pool_mixer(v_p, w_pool, pool_scale)
    o_mem = memory_mixer(q_m, mem, g_mem, w_mem_kv, g_q_mem, g_k_mem)
    y = jnp.concatenate([o_nsa * jax.nn.silu(z_n),
                         o_pool * jax.nn.silu(z_p),
                         o_mem * jax.nn.silu(z_m)], axis=-1)
    return x + jnp.einsum('bse,ed->bsd', y, w_out)


def setup_inputs(seed: int = 0) -> dict:
    key = jax.random.key(seed)
    ks = jax.random.split(key, 24)
    f32 = jnp.float32
    L = DEPTH

    def nrm(k, shape, s):
        return jax.random.normal(k, shape, f32) * s

    def gain(k, shape):
        return 1.0 + 0.01 * jax.random.normal(k, shape, f32)

    x = nrm(ks[0], (BATCH, SEQ, D_MODEL), 1.0)
    mem = nrm(ks[1], (BATCH, MEM_LEN, D_MODEL), 1.0)
    positions = (jnp.arange(SEQ, dtype=jnp.int32)[None, :]
                 + jax.random.randint(ks[2], (BATCH, 1), 0, 1024, dtype=jnp.int32))
    return {
        "x": x,
        "mem": mem,
        "positions": positions,
        "g_norm": gain(ks[3], (L, D_MODEL)),
        "w_in": nrm(ks[4], (L, D_MODEL, IN_WIDTH), D_MODEL ** -0.5),
        "g_q_nsa": gain(ks[5], (L, HEAD_DIM)),
        "g_k_cmp": gain(ks[6], (L, HEAD_DIM)),
        "g_k_slc": gain(ks[7], (L, HEAD_DIM)),
        "g_k_win": gain(ks[8], (L, HEAD_DIM)),
        "cmp_pos_k": nrm(ks[9], (L, CMP_LEN, HEAD_DIM), 0.1),
        "w_cmp_k1": nrm(ks[10], (L, CMP_LEN, HEAD_DIM, HEAD_DIM), (CMP_LEN * HEAD_DIM) ** -0.5),
        "w_cmp_k2": nrm(ks[11], (L, HEAD_DIM, HEAD_DIM), HEAD_DIM ** -0.5),
        "cmp_pos_v": nrm(ks[12], (L, CMP_LEN, HEAD_DIM), 0.1),
        "w_cmp_v1": nrm(ks[13], (L, CMP_LEN, HEAD_DIM, HEAD_DIM), (CMP_LEN * HEAD_DIM) ** -0.5),
        "w_cmp_v2": nrm(ks[14], (L, HEAD_DIM, HEAD_DIM), HEAD_DIM ** -0.5),
        "w_pool": nrm(ks[15], (L, POOL_GROUPS, POOL_GROUP_DIM, POOL_GROUP_DIM), POOL_GROUP_DIM ** -0.5),
        "pool_scale": gain(ks[16], (L, POOL_WIDTH)),
        "g_mem": gain(ks[17], (L, D_MODEL)),
        "w_mem_kv": nrm(ks[18], (L, D_MODEL, 2 * MEM_WIDTH), D_MODEL ** -0.5),
        "g_q_mem": gain(ks[19], (L, HEAD_DIM)),
        "g_k_mem": gain(ks[20], (L, HEAD_DIM)),
        "w_out": nrm(ks[21], (L, MIX_WIDTH, D_MODEL), MIX_WIDTH ** -0.5),
    }


def reference(x, mem, positions, g_norm, w_in, g_q_nsa, g_k_cmp, g_k_slc, g_k_win,
              cmp_pos_k, w_cmp_k1, w_cmp_k2, cmp_pos_v, w_cmp_v1, w_cmp_v2,
              w_pool, pool_scale, g_mem, w_mem_kv, g_q_mem, g_k_mem, w_out):
    for l in range(DEPTH):
        x = hybrid_layer(x, mem, positions, g_norm[l], w_in[l], g_q_nsa[l], g_k_cmp[l],
                         g_k_slc[l], g_k_win[l], cmp_pos_k[l], w_cmp_k1[l], w_cmp_k2[l],
                         cmp_pos_v[l], w_cmp_v1[l], w_cmp_v2[l], w_pool[l], pool_scale[l],
                         g_mem[l], w_mem_kv[l], g_q_mem[l], g_k_mem[l], w_out[l])
    return x
```

```cpp
#include <hip/hip_runtime.h>
#include <hip/hip_cooperative_groups.h>
#include <cstdio>
namespace cg = cooperative_groups;

#define DI __device__ __forceinline__
typedef unsigned short bf16_t;
typedef short bf16x8 __attribute__((ext_vector_type(8)));
typedef short s16x4 __attribute__((ext_vector_type(4)));
typedef float f32x4 __attribute__((ext_vector_type(4)));

#ifndef EN_POOL
#define EN_POOL 1
#endif
#ifndef EN_MEM
#define EN_MEM 1
#endif
#ifndef EN_NSA
#define EN_NSA 1
#endif
#ifndef EN_CMP
#define EN_CMP 1
#endif
#ifndef EN_SEL
#define EN_SEL 1
#endif
#ifndef EN_WIN
#define EN_WIN 1
#endif

constexpr int SEQ = 8192;
constexpr int NB = 8;
constexpr int NTOK = NB * SEQ;
constexpr int DM = 1024;
constexpr int INW = 2840;
constexpr int NFP = 2944;
constexpr int MEML = 256;
constexpr int NMEMTOK = NB * MEML;
constexpr int NCP = 512;

constexpr size_t al256(size_t x) { return (x + 255) & ~(size_t)255; }
constexpr size_t OFF_XB    = 0;
constexpr size_t OFF_WTIN  = OFF_XB    + al256((size_t)NTOK * DM * 2);
constexpr size_t OFF_WTOUT = OFF_WTIN  + al256((size_t)NFP * DM * 2);
constexpr size_t OFF_MH    = OFF_WTOUT + al256((size_t)DM * DM * 2);
constexpr size_t OFF_WTMKV = OFF_MH    + al256((size_t)NMEMTOK * DM * 2);
constexpr size_t OFF_WC1K  = OFF_WTMKV + al256((size_t)512 * DM * 2);
constexpr size_t OFF_WC1V  = OFF_WC1K  + al256((size_t)64 * 2048 * 2);
constexpr size_t OFF_WC2K  = OFF_WC1V  + al256((size_t)64 * 2048 * 2);
constexpr size_t OFF_WC2V  = OFF_WC2K  + al256((size_t)64 * 64 * 2);
constexpr size_t OFF_WPOOL = OFF_WC2V  + al256((size_t)64 * 64 * 2);
constexpr size_t OFF_BIASC = OFF_WPOOL + al256((size_t)4 * 64 * 64 * 2);
constexpr size_t OFF_ROPE  = OFF_BIASC + al256((size_t)128 * 4);
constexpr size_t OFF_QN    = OFF_ROPE  + al256((size_t)NTOK * 16 * 4);
constexpr size_t OFF_KCRAW = OFF_QN    + al256((size_t)NTOK * 512 * 2);
constexpr size_t OFF_VCRAW = OFF_KCRAW + al256((size_t)NTOK * 128 * 2);
constexpr size_t OFF_KS    = OFF_VCRAW + al256((size_t)NTOK * 128 * 2);
constexpr size_t OFF_VST   = OFF_KS    + al256((size_t)NTOK * 128 * 2);
constexpr size_t OFF_KW    = OFF_VST   + al256((size_t)NTOK * 128 * 2);
constexpr size_t OFF_VWT   = OFF_KW    + al256((size_t)NTOK * 128 * 2);
constexpr size_t OFF_ZS    = OFF_VWT   + al256((size_t)NTOK * 128 * 2);
constexpr size_t OFF_VP    = OFF_ZS    + al256((size_t)NTOK * 1024 * 2);
constexpr size_t OFF_QM    = OFF_VP    + al256((size_t)NTOK * 256 * 2);
constexpr size_t OFF_GATES = OFF_QM    + al256((size_t)NTOK * 256 * 2);
constexpr size_t OFF_KC    = OFF_GATES + al256((size_t)NTOK * 24 * 4);
constexpr size_t OFF_VCT   = OFF_KC    + al256((size_t)16 * NCP * 64 * 2);
constexpr size_t OFF_MK    = OFF_VCT   + al256((size_t)16 * 64 * NCP * 2);
constexpr size_t OFF_MVT   = OFF_MK    + al256((size_t)32 * MEML * 64 * 2);
constexpr size_t OFF_Y     = OFF_MVT   + al256((size_t)32 * 64 * MEML * 2);
constexpr size_t OFF_CNT   = OFF_Y     + al256((size_t)NTOK * 1024 * 2);
constexpr size_t WS_NEED   = OFF_CNT   + 256;

struct Params {
  const float* x; const float* mem; const int* pos;
  const float* g_norm; const float* w_in; const float* g_q_nsa; const float* g_k_cmp; const float* g_k_slc; const float* g_k_win;
  const float* cmp_pos_k; const float* w_cmp_k1; const float* w_cmp_k2; const float* cmp_pos_v; const float* w_cmp_v1; const float* w_cmp_v2;
  const float* w_pool; const float* pool_scale; const float* g_mem; const float* w_mem_kv; const float* g_q_mem; const float* g_k_mem; const float* w_out;
  float* out;
  unsigned char* ws;
};

DI int otid() { int t = threadIdx.x; asm volatile("" : "+v"(t)); return t; }
DI bf16_t f2bf(float f) { unsigned u = __float_as_uint(f); u += 0x7fffu + ((u >> 16) & 1u); return (bf16_t)(u >> 16); }
DI float bf2f(bf16_t h) { return __uint_as_float(((unsigned)h) << 16); }
DI unsigned pack2(float a, float b) { return (unsigned)f2bf(a) | ((unsigned)f2bf(b) << 16); }
DI f32x4 mfma16(bf16x8 a, bf16x8 b, f32x4 c) { return __builtin_amdgcn_mfma_f32_16x16x32_bf16(a, b, c, 0, 0, 0); }
DI float shx(float v, int m) { return __shfl_xor(v, m, 64); }
DI float silu_f(float z) { return z / (1.f + __expf(-z)); }
DI float sigmoid_f(float z) { return 1.f / (1.f + __expf(-z)); }
DI float gelu_tanh(float x) {
  float u = 0.7978845608028654f * (x + 0.044715f * x * x * x);
  float t = 1.f - 2.f / (__expf(2.f * u) + 1.f);
  return 0.5f * x * (1.f + t);
}
DI bf16x8 pack8(f32x4 a, f32x4 b) {
  uint4 p; p.x = pack2(a[0], a[1]); p.y = pack2(a[2], a[3]); p.z = pack2(b[0], b[1]); p.w = pack2(b[2], b[3]);
  return __builtin_bit_cast(bf16x8, p);
}
DI bf16x8 ld16(const void* p) { return *(const bf16x8*)p; }
DI bf16x8 ld8x2(const void* p0, const void* p1) {
  uint2 a = *(const uint2*)p0; uint2 b = *(const uint2*)p1;
  uint4 r; r.x = a.x; r.y = a.y; r.z = b.x; r.w = b.y;
  return __builtin_bit_cast(bf16x8, r);
}
DI void st4bf(bf16_t* dst, float a, float b, float c, float d) {
  uint2 v; v.x = pack2(a, b); v.y = pack2(c, d); *(uint2*)dst = v;
}

DI void p0_row_norm(const Params& P, int row) {
  const int lane = otid() & 63;
  const bool is_x = row < NTOK;
  const float* src = is_x ? (P.x + (size_t)row * DM) : (P.mem + (size_t)(row - NTOK) * DM);
  bf16_t* dst = is_x ? ((bf16_t*)(P.ws + OFF_XB) + (size_t)row * DM) : ((bf16_t*)(P.ws + OFF_MH) + (size_t)(row - NTOK) * DM);
  float4 v[4];
  float ss = 0.f;
#pragma unroll
  for (int u = 0; u < 4; ++u) {
    v[u] = *(const float4*)(src + lane * 4 + 256 * u);
    ss += v[u].x * v[u].x + v[u].y * v[u].y + v[u].z * v[u].z + v[u].w * v[u].w;
  }
#pragma unroll
  for (int m = 32; m >= 1; m >>= 1) ss += shx(ss, m);
  const float rinv = rsqrtf(ss * (1.f / 1024.f) + 1e-6f);
#pragma unroll
  for (int u = 0; u < 4; ++u) st4bf(dst + lane * 4 + 256 * u, v[u].x * rinv, v[u].y * rinv, v[u].z * rinv, v[u].w * rinv);
  if (is_x && lane < 8) {
    float invf = 1.0f;
    if (lane == 1) invf = 0.19392274f; else if (lane == 2) invf = 0.03760603f; else if (lane == 3) invf = 0.0072926646f;
    else if (lane == 4) invf = 0.0014142136f; else if (lane == 5) invf = 0.0002742482f; else if (lane == 6) invf = 5.3182957e-05f;
    else if (lane == 7) invf = 1.0313385e-05f;
    const float ang = (float)P.pos[row] * invf;
    const double a = (double)ang;
    const double k = rint(a * 0.15915494309189535);
    const float r = (float)(a - k * 6.283185307179586);
    float* rt = (float*)(P.ws + OFF_ROPE) + (size_t)row * 16;
    rt[lane] = cosf(r);
    rt[8 + lane] = sinf(r);
  }
}

DI void p0_transpose_tile(const float* src, int src_ld, int k0, int fsrc0, int nvalid, bf16_t* dst, int dst_ld, int fdst0,
                          const float* scale, unsigned char* smem) {
  float* tile = (float*)smem;
  const int tid = otid();
  const int r = tid >> 4, c4 = (tid & 15) * 4;
#pragma unroll
  for (int ps = 0; ps < 4; ++ps) {
    const int k = r + 16 * ps;
    float4 v = make_float4(0.f, 0.f, 0.f, 0.f);
    if (c4 < nvalid) v = *(const float4*)(src + (size_t)(k0 + k) * src_ld + fsrc0 + c4);
    const float sc = scale ? scale[k0 + k] : 1.f;
    tile[(c4 + 0) * 65 + k] = v.x * sc; tile[(c4 + 1) * 65 + k] = v.y * sc;
    tile[(c4 + 2) * 65 + k] = v.z * sc; tile[(c4 + 3) * 65 + k] = v.w * sc;
  }
  __syncthreads();
  const int f = tid >> 2, kc = (tid & 3) * 16;
  bf16_t* d = dst + (size_t)(fdst0 + f) * dst_ld + k0 + kc;
#pragma unroll
  for (int q = 0; q < 4; ++q) st4bf(d + 4 * q, tile[f * 65 + kc + 4 * q], tile[f * 65 + kc + 4 * q + 1], tile[f * 65 + kc + 4 * q + 2], tile[f * 65 + kc + 4 * q + 3]);
  __syncthreads();
}

DI void p0_transpose_item(const Params& P, int t, unsigned char* smem) {
  unsigned char* ws = P.ws;
  bf16_t* wtin = (bf16_t*)(ws + OFF_WTIN);
  if (t < 320) { p0_transpose_tile(P.w_in, INW, (t / 20) * 64, (t % 20) * 64, 64, wtin, DM, (t % 20) * 64, P.g_norm, smem); return; }
  t -= 320;
  if (t < 384) { p0_transpose_tile(P.w_in, INW, (t / 24) * 64, 1304 + (t % 24) * 64, 64, wtin, DM, 1280 + (t % 24) * 64, P.g_norm, smem); return; }
  t -= 384;
  if (t < 32) { const int ft = t & 1; p0_transpose_tile(P.w_in, INW, (t >> 1) * 64, 1280, ft == 0 ? 24 : 0, wtin, DM, 2816 + ft * 64, P.g_norm, smem); return; }
  t -= 32;
  if (t < 256) { p0_transpose_tile(P.w_out, DM, (t >> 4) * 64, (t & 15) * 64, 64, (bf16_t*)(ws + OFF_WTOUT), DM, (t & 15) * 64, nullptr, smem); return; }
  t -= 256;
  if (t < 128) { p0_transpose_tile(P.w_mem_kv, 512, (t >> 3) * 64, (t & 7) * 64, 64, (bf16_t*)(ws + OFF_WTMKV), DM, (t & 7) * 64, P.g_mem, smem); return; }
  t -= 128;
  if (t < 32) { p0_transpose_tile(P.w_cmp_k1, 64, t * 64, 0, 64, (bf16_t*)(ws + OFF_WC1K), 2048, 0, nullptr, smem); return; }
  t -= 32;
  if (t < 32) { p0_transpose_tile(P.w_cmp_v1, 64, t * 64, 0, 64, (bf16_t*)(ws + OFF_WC1V), 2048, 0, nullptr, smem); return; }
  t -= 32;
  if (t == 0) { p0_transpose_tile(P.w_cmp_k2, 64, 0, 0, 64, (bf16_t*)(ws + OFF_WC2K), 64, 0, nullptr, smem); return; }
  if (t == 1) { p0_transpose_tile(P.w_cmp_v2, 64, 0, 0, 64, (bf16_t*)(ws + OFF_WC2V), 64, 0, nullptr, smem); return; }
  t -= 2;
  if (t < 4) { p0_transpose_tile(P.w_pool + (size_t)t * 4096, 64, 0, 0, 64, (bf16_t*)(ws + OFF_WPOOL) + (size_t)t * 4096, 64, 0, nullptr, smem); return; }
}
constexpr int P0_NT = 320 + 384 + 32 + 256 + 128 + 32 + 32 + 2 + 4;

DI void p0_bias_item(const Params& P, int it, unsigned char* smem) {
  const int which = it >> 6, e = it & 63, tid = otid();
  const float* pe = which ? P.cmp_pos_v : P.cmp_pos_k;
  const float* w1 = which ? P.w_cmp_v1 : P.w_cmp_k1;
  float s = 0.f;
  for (int k = tid; k < 2048; k += 256) s += pe[k] * w1[(size_t)k * 64 + e];
#pragma unroll
  for (int m = 32; m >= 1; m >>= 1) s += shx(s, m);
  float* red = (float*)smem;
  __syncthreads();
  if ((tid & 63) == 0) red[tid >> 6] = s;
  __syncthreads();
  if (tid == 0) ((float*)(P.ws + OFF_BIASC))[it] = red[0] + red[1] + red[2] + red[3];
  __syncthreads();
}

DI void gemm_mainloop(const bf16_t* __restrict__ A, const bf16_t* __restrict__ Bm, const int K, unsigned char* smem, f32x4 (&acc)[4][4]) {
  const int tid = otid(), lane = tid & 63, w = tid >> 6, l15 = lane & 15, lg = lane >> 4;
  const int wr = w >> 1, wc = w & 1;
  const int srow = tid >> 3, sc = tid & 7;
  uint4 ra0, ra1, ra2, ra3, rb0, rb1, rb2, rb3;
#pragma unroll
  for (int i = 0; i < 4; ++i)
#pragma unroll
    for (int j = 0; j < 4; ++j) acc[i][j] = (f32x4){0.f, 0.f, 0.f, 0.f};
  const bf16_t* ap = A + (size_t)srow * K + sc * 8;
  const bf16_t* bp = Bm + (size_t)srow * K + sc * 8;
  const int nk = K >> 6;
#define GLOAD(kt) { const bf16_t* a_ = ap + (kt) * 64; const bf16_t* b_ = bp + (kt) * 64; \
    ra0 = *(const uint4*)(a_); ra1 = *(const uint4*)(a_ + (size_t)32 * K); ra2 = *(const uint4*)(a_ + (size_t)64 * K); ra3 = *(const uint4*)(a_ + (size_t)96 * K); \
    rb0 = *(const uint4*)(b_); rb1 = *(const uint4*)(b_ + (size_t)32 * K); rb2 = *(const uint4*)(b_ + (size_t)64 * K); rb3 = *(const uint4*)(b_ + (size_t)96 * K); }
#define SWRITE(buf) { unsigned char* sa_ = smem + (buf) * 36864 + srow * 144 + sc * 16; \
    *(uint4*)(sa_) = ra0; *(uint4*)(sa_ + 32 * 144) = ra1; *(uint4*)(sa_ + 64 * 144) = ra2; *(uint4*)(sa_ + 96 * 144) = ra3; \
    *(uint4*)(sa_ + 18432) = rb0; *(uint4*)(sa_ + 18432 + 32 * 144) = rb1; *(uint4*)(sa_ + 18432 + 64 * 144) = rb2; *(uint4*)(sa_ + 18432 + 96 * 144) = rb3; }
  GLOAD(0);
  SWRITE(0);
  __syncthreads();
#pragma unroll 1
  for (int kt = 0; kt < nk; ++kt) {
    const int buf = kt & 1;
    const bool more = (kt + 1 < nk);
    if (more) GLOAD(kt + 1);
    const unsigned char* sa = smem + buf * 36864 + (64 * wr + l15) * 144 + lg * 16;
    const unsigned char* sb = smem + buf * 36864 + 18432 + (64 * wc + l15) * 144 + lg * 16;
#pragma unroll
    for (int ks = 0; ks < 2; ++ks) {
      bf16x8 af[4], bfr[4];
#pragma unroll
      for (int i = 0; i < 4; ++i) { af[i] = ld16(sa + i * 16 * 144 + ks * 64); bfr[i] = ld16(sb + i * 16 * 144 + ks * 64); }
#pragma unroll
      for (int i = 0; i < 4; ++i)
#pragma unroll
        for (int j = 0; j < 4; ++j) acc[i][j] = mfma16(af[i], bfr[j], acc[i][j]);
    }
    if (more) SWRITE(buf ^ 1);
    __syncthreads();
  }
#undef GLOAD
#undef SWRITE
}

DI void head_norm_rope(f32x4 (&acc)[4][4], const float* gain, const float* ropeT, int tok0, bool rope, float outscale) {
  const int lane = otid() & 63, l15 = lane & 15, lg = lane >> 4;
  float gn[4][4];
#pragma unroll
  for (int mt = 0; mt < 4; ++mt) { float4 g4 = *(const float4*)(gain + 16 * mt + 4 * lg); gn[mt][0] = g4.x; gn[mt][1] = g4.y; gn[mt][2] = g4.z; gn[mt][3] = g4.w; }
#pragma unroll
  for (int nt = 0; nt < 4; ++nt) {
    float ss = 0.f;
#pragma unroll
    for (int mt = 0; mt < 4; ++mt)
#pragma unroll
      for (int i = 0; i < 4; ++i) ss += acc[mt][nt][i] * acc[mt][nt][i];
    ss += shx(ss, 16); ss += shx(ss, 32);
    const float rinv = rsqrtf(ss * (1.f / 64.f) + 1e-6f);
#pragma unroll
    for (int mt = 0; mt < 4; ++mt)
#pragma unroll
      for (int i = 0; i < 4; ++i) acc[mt][nt][i] = acc[mt][nt][i] * rinv * gn[mt][i];
    if (rope) {
      const float* rt = ropeT + (size_t)(tok0 + 16 * nt + l15) * 16 + 4 * (lg & 1);
      const float4 c4 = *(const float4*)rt, s4 = *(const float4*)(rt + 8);
      const float cs[4] = {c4.x, c4.y, c4.z, c4.w}, sn[4] = {s4.x, s4.y, s4.z, s4.w};
#pragma unroll
      for (int i = 0; i < 4; ++i) {
        const float own = acc[0][nt][i];
        const float oth = shx(own, 32);
        acc[0][nt][i] = (lg < 2) ? (own * cs[i] - oth * sn[i]) : (oth * sn[i] + own * cs[i]);
      }
    }
#pragma unroll
    for (int mt = 0; mt < 4; ++mt)
#pragma unroll
      for (int i = 0; i < 4; ++i) acc[mt][nt][i] *= outscale;
  }
}

DI void store_rowmajor(const f32x4 (&acc)[4][4], bf16_t* dst, size_t ld) {
  const int lane = otid() & 63, l15 = lane & 15, lg = lane >> 4;
#pragma unroll
  for (int nt = 0; nt < 4; ++nt)
#pragma unroll
    for (int mt = 0; mt < 4; ++mt)
      st4bf(dst + (size_t)(16 * nt + l15) * ld + 16 * mt + 4 * lg, acc[mt][nt][0], acc[mt][nt][1], acc[mt][nt][2], acc[mt][nt][3]);
}
DI void store_transposed(const f32x4 (&acc)[4][4], bf16_t* dst, size_t ld) {
  const int lane = otid() & 63, l15 = lane & 15, lg = lane >> 4;
#pragma unroll
  for (int nt = 0; nt < 4; ++nt)
#pragma unroll
    for (int mt = 0; mt < 4; ++mt)
#pragma unroll
      for (int i = 0; i < 4; ++i) dst[(size_t)(16 * mt + 4 * lg + i) * ld + 16 * nt + l15] = f2bf(acc[mt][nt][i]);
}

DI void p1_inproj_item(const Params& P, int item, unsigned char* smem) {
  unsigned char* ws = P.ws;
  const int mtile = item / 23, ntile = item % 23;
  f32x4 acc[4][4];
  gemm_mainloop((const bf16_t*)(ws + OFF_WTIN) + (size_t)ntile * 128 * DM, (const bf16_t*)(ws + OFF_XB) + (size_t)mtile * 128 * DM, DM, smem, acc);
  const int w = otid() >> 6, lane = otid() & 63, l15 = lane & 15, lg = lane >> 4;
  const int ft = ntile * 2 + (w >> 1);
  const int tok0 = mtile * 128 + (w & 1) * 64;
  const int b = tok0 >> 13, s0 = tok0 & (SEQ - 1);
  const float* ropeT = (const float*)(ws + OFF_ROPE);
  if (ft < 8) {
    head_norm_rope(acc, P.g_q_nsa, ropeT, tok0, true, 0.125f);
    store_rowmajor(acc, (bf16_t*)(ws + OFF_QN) + ((size_t)(b * 8 + ft) * SEQ + s0) * 64, 64);
  } else if (ft < 20) {
    const int idx = (ft - 8) >> 1, gi = (ft - 8) & 1;
    const size_t rm = ((size_t)(b * 2 + gi) * SEQ + s0) * 64;
    const size_t tr = (size_t)(b * 2 + gi) * 64 * SEQ + s0;
    if (idx == 0) store_rowmajor(acc, (bf16_t*)(ws + OFF_KCRAW) + rm, 64);
    else if (idx == 1) store_rowmajor(acc, (bf16_t*)(ws + OFF_VCRAW) + rm, 64);
    else if (idx == 2) { head_norm_rope(acc, P.g_k_slc, ropeT, tok0, true, 1.f); store_rowmajor(acc, (bf16_t*)(ws + OFF_KS) + rm, 64); }
    else if (idx == 3) store_transposed(acc, (bf16_t*)(ws + OFF_VST) + tr, SEQ);
    else if (idx == 4) { head_norm_rope(acc, P.g_k_win, ropeT, tok0, true, 1.f); store_rowmajor(acc, (bf16_t*)(ws + OFF_KW) + rm, 64); }
    else store_transposed(acc, (bf16_t*)(ws + OFF_VWT) + tr, SEQ);
  } else if (ft < 28 || (ft >= 32 && ft < 36) || (ft >= 40 && ft < 44)) {
    const int zoff = (ft < 28) ? (ft - 20) * 64 : (ft < 36 ? 512 + (ft - 32) * 64 : 768 + (ft - 40) * 64);
#pragma unroll
    for (int mt = 0; mt < 4; ++mt)
#pragma unroll
      for (int nt = 0; nt < 4; ++nt)
#pragma unroll
        for (int i = 0; i < 4; ++i) acc[mt][nt][i] = silu_f(acc[mt][nt][i]);
    store_rowmajor(acc, (bf16_t*)(ws + OFF_ZS) + (size_t)tok0 * 1024 + zoff, 1024);
  } else if (ft < 32) {
    store_rowmajor(acc, (bf16_t*)(ws + OFF_VP) + (size_t)tok0 * 256 + (ft - 28) * 64, 256);
  } else if (ft < 40) {
    head_norm_rope(acc, P.g_q_mem, ropeT, tok0, false, 0.125f);
    store_rowmajor(acc, (bf16_t*)(ws + OFF_QM) + ((size_t)(b * 4 + (ft - 36)) * SEQ + s0) * 64, 64);
  } else if (ft == 44) {
    float* gt = (float*)(ws + OFF_GATES);
#pragma unroll
    for (int nt = 0; nt < 4; ++nt)
#pragma unroll
      for (int mt = 0; mt < 2; ++mt)
#pragma unroll
        for (int i = 0; i < 4; ++i) {
          const int f = 16 * mt + 4 * lg + i;
          if (f < 24) gt[(size_t)(tok0 + 16 * nt + l15) * 24 + f] = sigmoid_f(acc[mt][nt][i]);
        }
  }
}

DI void p1_memkv_item(const Params& P, int item, unsigned char* smem) {
  unsigned char* ws = P.ws;
  const int mtile = item >> 2, ntile = item & 3;
  f32x4 acc[4][4];
  gemm_mainloop((const bf16_t*)(ws + OFF_WTMKV) + (size_t)ntile * 128 * DM, (const bf16_t*)(ws + OFF_MH) + (size_t)mtile * 128 * DM, DM, smem, acc);
  const int w = otid() >> 6;
  const int ft = ntile * 2 + (w >> 1);
  const int tok0 = mtile * 128 + (w & 1) * 64;
  const int b = tok0 >> 8, m0 = tok0 & 255;
  if (ft < 4) {
    head_norm_rope(acc, P.g_k_mem, nullptr, 0, false, 1.f);
    store_rowmajor(acc, (bf16_t*)(ws + OFF_MK) + ((size_t)(b * 4 + ft) * MEML + m0) * 64, 64);
  } else {
    store_transposed(acc, (bf16_t*)(ws + OFF_MVT) + (size_t)(b * 4 + (ft - 4)) * 64 * MEML + m0, MEML);
  }
}

DI void p2_compress_item(const Params& P, int item) {
  unsigned char* ws = P.ws;
  const int which = item >> 7, bg = (item >> 3) & 15, ntile = item & 7;
  const int tid = otid(), lane = tid & 63, w = tid >> 6, l15 = lane & 15, lg = lane >> 4;
  const int n = ntile * 64 + w * 16 + l15;
  const int nc = n < 511 ? n : 510;
  const bf16_t* raw = (const bf16_t*)(ws + (which ? OFF_VCRAW : OFF_KCRAW)) + ((size_t)bg * SEQ + 16 * nc) * 64 + 8 * lg;
  const bf16_t* w1 = (const bf16_t*)(ws + (which ? OFF_WC1V : OFF_WC1K)) + (size_t)l15 * 2048 + 8 * lg;
  f32x4 acc[4];
#pragma unroll
  for (int i = 0; i < 4; ++i) acc[i] = (f32x4){0.f, 0.f, 0.f, 0.f};
#pragma unroll 4
  for (int ks = 0; ks < 64; ++ks) {
    const bf16x8 bq = ld16(raw + ks * 32);
#pragma unroll
    for (int mt = 0; mt < 4; ++mt) acc[mt] = mfma16(ld16(w1 + (size_t)mt * 16 * 2048 + ks * 32), bq, acc[mt]);
  }
  const float* bias = (const float*)(ws + OFF_BIASC) + which * 64;
#pragma unroll
  for (int mt = 0; mt < 4; ++mt)
#pragma unroll
    for (int i = 0; i < 4; ++i) acc[mt][i] = gelu_tanh(acc[mt][i] + bias[16 * mt + 4 * lg + i]);
  const bf16_t* w2 = (const bf16_t*)(ws + (which ? OFF_WC2V : OFF_WC2K)) + (size_t)l15 * 64 + 4 * lg;
  f32x4 a2[4];
#pragma unroll
  for (int i = 0; i < 4; ++i) a2[i] = (f32x4){0.f, 0.f, 0.f, 0.f};
#pragma unroll
  for (int ks2 = 0; ks2 < 2; ++ks2) {
    const bf16x8 hb = pack8(acc[2 * ks2], acc[2 * ks2 + 1]);
#pragma unroll
    for (int ft = 0; ft < 4; ++ft) {
      const bf16_t* wp = w2 + (size_t)ft * 16 * 64 + 32 * ks2;
      a2[ft] = mfma16(ld8x2(wp, wp + 16), hb, a2[ft]);
    }
  }
  const int b = bg >> 1;
  if (which == 0) {
    float ss = 0.f;
#pragma unroll
    for (int ft = 0; ft < 4; ++ft)
#pragma unroll
      for (int i = 0; i < 4; ++i) ss += a2[ft][i] * a2[ft][i];
    ss += shx(ss, 16); ss += shx(ss, 32);
    const float rinv = rsqrtf(ss * (1.f / 64.f) + 1e-6f);
#pragma unroll
    for (int ft = 0; ft < 4; ++ft) {
      const float4 g4 = *(const float4*)(P.g_k_cmp + 16 * ft + 4 * lg);
      a2[ft][0] *= rinv * g4.x; a2[ft][1] *= rinv * g4.y; a2[ft][2] *= rinv * g4.z; a2[ft][3] *= rinv * g4.w;
    }
    const float* rt = (const float*)(ws + OFF_ROPE) + ((size_t)b * SEQ + 16 * nc + 31) * 16 + 4 * (lg & 1);
    const float4 c4 = *(const float4*)rt, s4 = *(const float4*)(rt + 8);
    const float cs[4] = {c4.x, c4.y, c4.z, c4.w}, sn[4] = {s4.x, s4.y, s4.z, s4.w};
#pragma unroll
    for (int i = 0; i < 4; ++i) {
      const float own = a2[0][i];
      const float oth = shx(own, 32);
      a2[0][i] = (lg < 2) ? (own * cs[i] - oth * sn[i]) : (oth * sn[i] + own * cs[i]);
    }
    bf16_t* dst = (bf16_t*)(ws + OFF_KC) + ((size_t)bg * NCP + n) * 64 + 4 * lg;
    const float z = (n < 511) ? 1.f : 0.f;
#pragma unroll
    for (int ft = 0; ft < 4; ++ft) st4bf(dst + 16 * ft, a2[ft][0] * z, a2[ft][1] * z, a2[ft][2] * z, a2[ft][3] * z);
  } else {
    bf16_t* dst = (bf16_t*)(ws + OFF_VCT) + (size_t)bg * 64 * NCP + n;
    const float z = (n < 511) ? 1.f : 0.f;
#pragma unroll
    for (int ft = 0; ft < 4; ++ft)
#pragma unroll
      for (int i = 0; i < 4; ++i) dst[(size_t)(16 * ft + 4 * lg + i) * NCP] = f2bf(a2[ft][i] * z);
  }
}

enum { M_WIN = 0, M_SEL = 1, M_MEM = 2, M_CMPA = 3, M_CMPB = 4 };
constexpr int SM_IMP = 36864;
constexpr int SM_SEL = SM_IMP + 32 * 129 * 4;

template <int MODE>
DI void attn_run(const bf16_t* __restrict__ kbase, const bf16_t* __restrict__ vbase, const int vstride,
                 const int tile_begin, const int tile_end,
                 const bf16x8 (&qf)[2][2], const int (&tq)[2], const int (&tokl)[2],
                 f32x4 (&o)[2][4], float (&m)[2], float (&l)[2], unsigned char* smem) {
  if (tile_begin >= tile_end) return;
  const int tid = otid(), lane = tid & 63, l15 = lane & 15, lg = lane >> 4;
  const int srow = tid >> 3, sc = tid & 7;
  uint4 rk0, rk1, rv0 = make_uint4(0,0,0,0), rv1 = make_uint4(0,0,0,0);
  const unsigned short* selbits = (const unsigned short*)(smem + SM_SEL);
  float* imp = (float*)(smem + SM_IMP);
#define AGLOAD(t) { const bf16_t* k_ = kbase + ((size_t)((t) * 64 + srow)) * 64 + sc * 8; rk0 = *(const uint4*)(k_); rk1 = *(const uint4*)(k_ + 32 * 64); \
      if (MODE != M_CMPA) { const bf16_t* v_ = vbase + (size_t)srow * vstride + (t) * 64 + sc * 8; rv0 = *(const uint4*)(v_); rv1 = *(const uint4*)(v_ + (size_t)32 * vstride); } }
#define ASWRITE(buf) { unsigned char* d_ = smem + (buf) * 9216 + srow * 144 + sc * 16; *(uint4*)(d_) = rk0; *(uint4*)(d_ + 32 * 144) = rk1; \
      if (MODE != M_CMPA) { *(uint4*)(d_ + 18432) = rv0; *(uint4*)(d_ + 18432 + 32 * 144) = rv1; } }
  AGLOAD(tile_begin);
  ASWRITE(0);
  __syncthreads();
#pragma unroll 1
  for (int t = tile_begin; t < tile_end; ++t) {
    const int buf = (t - tile_begin) & 1;
    const bool more = (t + 1 < tile_end);
    if (more) AGLOAD(t + 1);
    const unsigned char* ck = smem + buf * 9216 + l15 * 144 + lg * 16;
    const unsigned char* cv = smem + 18432 + buf * 9216 + l15 * 144 + lg * 8;
    bool need[2] = {true, true};
    bool bit[2] = {true, true};
    if (MODE == M_SEL) {
#pragma unroll
      for (int c = 0; c < 2; ++c) {
        bit[c] = (selbits[tokl[c] * 8 + (t >> 4)] >> (t & 15)) & 1;
        need[c] = __any(bit[c]) != 0;
      }
    }
    if (need[0] || need[1]) {
      f32x4 s[2][4];
#pragma unroll
      for (int c = 0; c < 2; ++c)
#pragma unroll
        for (int kt = 0; kt < 4; ++kt) s[c][kt] = (f32x4){0.f, 0.f, 0.f, 0.f};
#pragma unroll
      for (int ks = 0; ks < 2; ++ks)
#pragma unroll
        for (int kt = 0; kt < 4; ++kt) {
          const bf16x8 a = ld16(ck + kt * 16 * 144 + ks * 64);
          s[0][kt] = mfma16(a, qf[0][ks], s[0][kt]);
          s[1][kt] = mfma16(a, qf[1][ks], s[1][kt]);
        }
      bf16x8 pf[2][2];
#pragma unroll
      for (int c = 0; c < 2; ++c) {
        const int key0 = t * 64 + 4 * lg;
        float mx = -__builtin_inff();
#pragma unroll
        for (int kt = 0; kt < 4; ++kt)
#pragma unroll
          for (int i = 0; i < 4; ++i) {
            const int kk = key0 + 16 * kt + i;
            bool ok = true;
            if (MODE == M_WIN) ok = (kk <= tq[c]) && (kk > tq[c] - 512);
            if (MODE == M_SEL) ok = bit[c] && (kk <= tq[c]);
            if (MODE == M_CMPA || MODE == M_CMPB) ok = (16 * kk + 31 <= tq[c]);
            const float sv = ok ? s[c][kt][i] : -__builtin_inff();
            s[c][kt][i] = sv;
            mx = fmaxf(mx, sv);
          }
        float msafe, scl = 1.f;
        if (MODE == M_CMPB) {
          msafe = (m[c] == -__builtin_inff()) ? 0.f : m[c];
          scl = l[c];
        } else {
          mx = fmaxf(mx, shx(mx, 16)); mx = fmaxf(mx, shx(mx, 32));
          const float mnew = fmaxf(m[c], mx);
          msafe = (mnew == -__builtin_inff()) ? 0.f : mnew;
          const float alpha = __expf(m[c] - msafe);
          m[c] = mnew;
          l[c] *= alpha;
          if (MODE != M_CMPA) {
#pragma unroll
            for (int dt = 0; dt < 4; ++dt) o[c][dt] *= alpha;
          }
        }
        float psum = 0.f;
#pragma unroll
        for (int kt = 0; kt < 4; ++kt)
#pragma unroll
          for (int i = 0; i < 4; ++i) {
            const float p = __expf(s[c][kt][i] - msafe) * scl;
            s[c][kt][i] = p;
            psum += p;
          }
        if (MODE != M_CMPB) l[c] += psum;
        if (MODE == M_CMPB) {
#pragma unroll
          for (int kt = 0; kt < 4; ++kt) {
            float pa = s[c][kt][0] + s[c][kt][1] + s[c][kt][2] + 0.5f * s[c][kt][3];
            float pb = 0.5f * s[c][kt][3];
            pa += shx(pa, 1); pa += shx(pa, 2);
            pb += shx(pb, 1); pb += shx(pb, 2);
            if ((lane & 3) == 0) {
              const int j = (key0 + 16 * kt) >> 2;
              atomicAdd(&imp[tokl[c] * 129 + j], pa);
              if (j + 1 < 128) atomicAdd(&imp[tokl[c] * 129 + j + 1], pb);
            }
          }
        }
        if (MODE != M_CMPA) {
          pf[c][0] = pack8(s[c][0], s[c][1]);
          pf[c][1] = pack8(s[c][2], s[c][3]);
        }
      }
      if (MODE != M_CMPA) {
#pragma unroll
        for (int ks2 = 0; ks2 < 2; ++ks2)
#pragma unroll
          for (int dt = 0; dt < 4; ++dt) {
            const unsigned char* vp = cv + dt * 16 * 144 + ks2 * 64;
            const bf16x8 a = ld8x2(vp, vp + 32);
            o[0][dt] = mfma16(a, pf[0][ks2], o[0][dt]);
            o[1][dt] = mfma16(a, pf[1][ks2], o[1][dt]);
          }
      }
    }
    if (more) ASWRITE(buf ^ 1);
    __syncthreads();
  }
#undef AGLOAD
#undef ASWRITE
}

DI void attn_reset(f32x4 (&o)[2][4], float (&m)[2], float (&l)[2]) {
#pragma unroll
  for (int c = 0; c < 2; ++c) {
    m[c] = -__builtin_inff(); l[c] = 0.f;
#pragma unroll
    for (int dt = 0; dt < 4; ++dt) o[c][dt] = (f32x4){0.f, 0.f, 0.f, 0.f};
  }
}
DI void attn_accum(f32x4 (&ot)[2][4], const f32x4 (&o)[2][4], const float (&l)[2], const float (&gate)[2]) {
#pragma unroll
  for (int c = 0; c < 2; ++c) {
    float lt = l[c]; lt += shx(lt, 16); lt += shx(lt, 32);
    const float f = gate[c] / fmaxf(lt, 1.17549435e-38f);
#pragma unroll
    for (int dt = 0; dt < 4; ++dt) ot[c][dt] += o[c][dt] * f;
  }
}

DI void topk_select(unsigned char* smem, int cur) {
  const int tid = otid(), lane = tid & 63, tok = tid >> 3, sub = tid & 7;
  const float* imp = (const float*)(smem + SM_IMP);
  unsigned short* selbits = (unsigned short*)(smem + SM_SEL);
  unsigned bits = 0;
  if (cur <= 15) {
#pragma unroll
    for (int q = 0; q < 16; ++q) if (16 * sub + q <= cur) bits |= 1u << q;
  } else {
    unsigned key[16];
#pragma unroll
    for (int q = 0; q < 16; ++q) {
      const int j = 16 * sub + q;
      const bool cand = (j >= 1) && (j <= cur - 2);
      key[q] = cand ? (__float_as_uint(imp[tok * 129 + j]) + 1u) : 0u;
    }
    unsigned T = 0;
#pragma unroll 1
    for (int b = 31; b >= 0; --b) {
      const unsigned cnd = T | (1u << b);
      int cnt = 0;
#pragma unroll
      for (int q = 0; q < 16; ++q) cnt += (key[q] >= cnd) ? 1 : 0;
      cnt += __shfl_xor(cnt, 1, 64); cnt += __shfl_xor(cnt, 2, 64); cnt += __shfl_xor(cnt, 4, 64);
      if (cnt >= 13) T = cnd;
    }
    int cgt = 0, ceq = 0;
#pragma unroll
    for (int q = 0; q < 16; ++q) { cgt += (key[q] > T) ? 1 : 0; ceq += (key[q] == T) ? 1 : 0; }
    int gt_tot = cgt;
    gt_tot += __shfl_xor(gt_tot, 1, 64); gt_tot += __shfl_xor(gt_tot, 2, 64); gt_tot += __shfl_xor(gt_tot, 4, 64);
    int pre = 0;
#pragma unroll
    for (int k = 0; k < 8; ++k) { const int v = __shfl(ceq, (lane & ~7) | k, 64); if (k < sub) pre += v; }
    const int quota = 13 - gt_tot;
#pragma unroll
    for (int q = 0; q < 16; ++q) {
      if (key[q] > T) bits |= 1u << q;
      else if (key[q] == T && T != 0u) { if (pre < quota) bits |= 1u << q; ++pre; }
    }
    if (sub == 0) bits |= 1u;
    if ((cur >> 4) == sub) bits |= 1u << (cur & 15);
    if (((cur - 1) >> 4) == sub) bits |= 1u << ((cur - 1) & 15);
  }
  selbits[tok * 8 + sub] = (unsigned short)bits;
}

DI void p3_nsa_item(const Params& P, int item, unsigned char* smem) {
  unsigned char* ws = P.ws;
  const int bg = item & 15, qt = 255 - (item >> 4);
  const int b = bg >> 1, gi = bg & 1, t0 = qt * 32, cur = qt >> 1;
  const int tid = otid(), lane = tid & 63, w = tid >> 6, l15 = lane & 15, lg = lane >> 4;
  int tokl[2], tq[2];
  bf16x8 qf[2][2];
  float gt[3][2];
  const int head = 4 * gi + (l15 & 3);
#pragma unroll
  for (int c = 0; c < 2; ++c) {
    tokl[c] = 8 * w + 4 * c + (l15 >> 2);
    tq[c] = t0 + tokl[c];
    const bf16_t* qp = (const bf16_t*)(ws + OFF_QN) + ((size_t)(b * 8 + head) * SEQ + tq[c]) * 64 + 8 * lg;
    qf[c][0] = ld16(qp); qf[c][1] = ld16(qp + 32);
    const float* gp = (const float*)(ws + OFF_GATES) + (size_t)(b * SEQ + tq[c]) * 24 + head * 3;
    gt[0][c] = gp[0]; gt[1][c] = gp[1]; gt[2][c] = gp[2];
  }
  f32x4 ot[2][4], o[2][4];
  float m[2], l[2];
#pragma unroll
  for (int c = 0; c < 2; ++c)
#pragma unroll
    for (int dt = 0; dt < 4; ++dt) ot[c][dt] = (f32x4){0.f, 0.f, 0.f, 0.f};
  float* imp = (float*)(smem + SM_IMP);
  for (int i = tid; i < 32 * 129; i += 256) imp[i] = 0.f;
  const bf16_t* kc = (const bf16_t*)(ws + OFF_KC) + (size_t)bg * NCP * 64;
  const bf16_t* vct = (const bf16_t*)(ws + OFF_VCT) + (size_t)bg * 64 * NCP;
  const int ctiles = (qt >> 5) + 1;
#if EN_CMP
  attn_reset(o, m, l);
  attn_run<M_CMPA>(kc, vct, NCP, 0, ctiles, qf, tq, tokl, o, m, l, smem);
#pragma unroll
  for (int c = 0; c < 2; ++c) { float lt = l[c]; lt += shx(lt, 16); lt += shx(lt, 32); l[c] = 1.f / fmaxf(lt, 1.17549435e-38f); }
  attn_run<M_CMPB>(kc, vct, NCP, 0, ctiles, qf, tq, tokl, o, m, l, smem);
#pragma unroll
  for (int c = 0; c < 2; ++c)
#pragma unroll
    for (int dt = 0; dt < 4; ++dt) ot[c][dt] += o[c][dt] * gt[0][c];
#else
  __syncthreads();
#endif
  topk_select(smem, cur);
  __syncthreads();
#if EN_SEL
  attn_reset(o, m, l);
  attn_run<M_SEL>((const bf16_t*)(ws + OFF_KS) + (size_t)bg * SEQ * 64, (const bf16_t*)(ws + OFF_VST) + (size_t)bg * 64 * SEQ, SEQ,
                  0, cur + 1, qf, tq, tokl, o, m, l, smem);
  attn_accum(ot, o, l, gt[1]);
#endif
#if EN_WIN
  attn_reset(o, m, l);
  attn_run<M_WIN>((const bf16_t*)(ws + OFF_KW) + (size_t)bg * SEQ * 64, (const bf16_t*)(ws + OFF_VWT) + (size_t)bg * 64 * SEQ, SEQ,
                  (t0 >= 511) ? ((t0 - 511) >> 6) : 0, cur + 1, qf, tq, tokl, o, m, l, smem);
  attn_accum(ot, o, l, gt[2]);
#endif
#pragma unroll
  for (int c = 0; c < 2; ++c) {
    const size_t off = (size_t)(b * SEQ + tq[c]) * 1024 + head * 64 + 4 * lg;
    const bf16_t* zp = (const bf16_t*)(ws + OFF_ZS) + off;
    bf16_t* yp = (bf16_t*)(ws + OFF_Y) + off;
#pragma unroll
    for (int dt = 0; dt < 4; ++dt) {
      const uint2 zz = *(const uint2*)(zp + 16 * dt);
      st4bf(yp + 16 * dt, ot[c][dt][0] * bf2f((bf16_t)(zz.x & 0xffff)), ot[c][dt][1] * bf2f((bf16_t)(zz.x >> 16)),
            ot[c][dt][2] * bf2f((bf16_t)(zz.y & 0xffff)), ot[c][dt][3] * bf2f((bf16_t)(zz.y >> 16)));
    }
  }
}

DI void p3_mem_item(const Params& P, int item, unsigned char* smem) {
  unsigned char* ws = P.ws;
  const int bh = item >> 6, qt = item & 63;
  const int b = bh >> 2, h = bh & 3, t0 = qt * 128;
  const int tid = otid(), lane = tid & 63, w = tid >> 6, l15 = lane & 15, lg = lane >> 4;
  int tokl[2], tq[2];
  bf16x8 qf[2][2];
#pragma unroll
  for (int c = 0; c < 2; ++c) {
    tokl[c] = 0;
    tq[c] = t0 + 32 * w + 16 * c + l15;
    const bf16_t* qp = (const bf16_t*)(ws + OFF_QM) + ((size_t)bh * SEQ + tq[c]) * 64 + 8 * lg;
    qf[c][0] = ld16(qp); qf[c][1] = ld16(qp + 32);
  }
  f32x4 o[2][4];
  float m[2], l[2];
  attn_reset(o, m, l);
  attn_run<M_MEM>((const bf16_t*)(ws + OFF_MK) + (size_t)bh * MEML * 64, (const bf16_t*)(ws + OFF_MVT) + (size_t)bh * 64 * MEML, MEML,
                  0, 4, qf, tq, tokl, o, m, l, smem);
#pragma unroll
  for (int c = 0; c < 2; ++c) {
    float lt = l[c]; lt += shx(lt, 16); lt += shx(lt, 32);
    const float f = 1.f / fmaxf(lt, 1.17549435e-38f);
    const size_t off = (size_t)(b * SEQ + tq[c]) * 1024 + 768 + h * 64 + 4 * lg;
    const bf16_t* zp = (const bf16_t*)(ws + OFF_ZS) + off;
    bf16_t* yp = (bf16_t*)(ws + OFF_Y) + off;
#pragma unroll
    for (int dt = 0; dt < 4; ++dt) {
      const uint2 zz = *(const uint2*)(zp + 16 * dt);
      st4bf(yp + 16 * dt, o[c][dt][0] * f * bf2f((bf16_t)(zz.x & 0xffff)), o[c][dt][1] * f * bf2f((bf16_t)(zz.x >> 16)),
            o[c][dt][2] * f * bf2f((bf16_t)(zz.y & 0xffff)), o[c][dt][3] * f * bf2f((bf16_t)(zz.y >> 16)));
    }
  }
}

DI void p3_pool_item(const Params& P, int item, unsigned char* smem) {
  unsigned char* ws = P.ws;
  const int tok0 = item * 64, s0 = tok0 & (SEQ - 1);
  const int tid = otid(), lane = tid & 63, w = tid >> 6, l15 = lane & 15, lg = lane >> 4;
  const bf16_t* vp = (const bf16_t*)(ws + OFF_VP);
  for (int q = tid; q < 79 * 32; q += 256) {
    const int r = q >> 5, cch = q & 31;
    const int s = s0 - 15 + r;
    uint4 v = make_uint4(0, 0, 0, 0);
    if (s >= 0) v = *(const uint4*)(vp + (size_t)(tok0 - 15 + r) * 256 + cch * 8);
    *(uint4*)(smem + r * 528 + cch * 16) = v;
  }
  __syncthreads();
  const int rown = 15 + 16 * w + l15;
  const int s = s0 + 16 * w + l15;
  const int tok = tok0 + 16 * w + l15;
#pragma unroll
  for (int gp = 0; gp < 4; ++gp) {
    const int win = 2 << gp;
    const float rc = 1.f / (float)((s + 1 < win) ? (s + 1) : win);
    f32x4 acc[4];
#pragma unroll
    for (int i = 0; i < 4; ++i) acc[i] = (f32x4){0.f, 0.f, 0.f, 0.f};
#pragma unroll
    for (int ks = 0; ks < 2; ++ks) {
      const int cb = (gp * 64 + 32 * ks + 8 * lg) * 2;
      float sum[8];
#pragma unroll
      for (int j = 0; j < 8; ++j) sum[j] = 0.f;
      uint4 own = make_uint4(0, 0, 0, 0);
      for (int i = 0; i < win; ++i) {
        const uint4 v = *(const uint4*)(smem + (rown - i) * 528 + cb);
        if (i == 0) own = v;
        sum[0] += bf2f((bf16_t)(v.x & 0xffff)); sum[1] += bf2f((bf16_t)(v.x >> 16));
        sum[2] += bf2f((bf16_t)(v.y & 0xffff)); sum[3] += bf2f((bf16_t)(v.y >> 16));
        sum[4] += bf2f((bf16_t)(v.z & 0xffff)); sum[5] += bf2f((bf16_t)(v.z >> 16));
        sum[6] += bf2f((bf16_t)(v.w & 0xffff)); sum[7] += bf2f((bf16_t)(v.w >> 16));
      }
      uint4 pk;
      pk.x = pack2(sum[0] * rc - bf2f((bf16_t)(own.x & 0xffff)), sum[1] * rc - bf2f((bf16_t)(own.x >> 16)));
      pk.y = pack2(sum[2] * rc - bf2f((bf16_t)(own.y & 0xffff)), sum[3] * rc - bf2f((bf16_t)(own.y >> 16)));
      pk.z = pack2(sum[4] * rc - bf2f((bf16_t)(own.z & 0xffff)), sum[5] * rc - bf2f((bf16_t)(own.z >> 16)));
      pk.w = pack2(sum[6] * rc - bf2f((bf16_t)(own.w & 0xffff)), sum[7] * rc - bf2f((bf16_t)(own.w >> 16)));
      const bf16x8 bq = __builtin_bit_cast(bf16x8, pk);
      const bf16_t* wp = (const bf16_t*)(ws + OFF_WPOOL) + (size_t)gp * 4096 + (size_t)l15 * 64 + 32 * ks + 8 * lg;
#pragma unroll
      for (int mt = 0; mt < 4; ++mt) acc[mt] = mfma16(ld16(wp + mt * 16 * 64), bq, acc[mt]);
    }
    const size_t off = (size_t)tok * 1024 + 512 + gp * 64 + 4 * lg;
    const bf16_t* zp = (const bf16_t*)(ws + OFF_ZS) + off;
    bf16_t* yp = (bf16_t*)(ws + OFF_Y) + off;
#pragma unroll
    for (int mt = 0; mt < 4; ++mt) {
      const float4 ps = *(const float4*)(P.pool_scale + gp * 64 + 16 * mt + 4 * lg);
      const uint2 zz = *(const uint2*)(zp + 16 * mt);
      st4bf(yp + 16 * mt, acc[mt][0] * ps.x * bf2f((bf16_t)(zz.x & 0xffff)), acc[mt][1] * ps.y * bf2f((bf16_t)(zz.x >> 16)),
            acc[mt][2] * ps.z * bf2f((bf16_t)(zz.y & 0xffff)), acc[mt][3] * ps.w * bf2f((bf16_t)(zz.y >> 16)));
    }
  }
  __syncthreads();
}

DI void p3_zero_y(const Params& P, int tok0, int col0, int ncol) {
  bf16_t* y = (bf16_t*)(P.ws + OFF_Y);
  const int per_row = ncol / 8;
  for (int q = otid(); q < 64 * per_row; q += 256) {
    const int r = q / per_row, cch = q % per_row;
    *(uint4*)(y + (size_t)(tok0 + r) * 1024 + col0 + cch * 8) = make_uint4(0, 0, 0, 0);
  }
}

DI void p4_outproj_item(const Params& P, int item, unsigned char* smem) {
  unsigned char* ws = P.ws;
  const int mtile = item >> 3, ntile = item & 7;
  f32x4 acc[4][4];
  gemm_mainloop((const bf16_t*)(ws + OFF_WTOUT) + (size_t)ntile * 128 * DM, (const bf16_t*)(ws + OFF_Y) + (size_t)mtile * 128 * DM, DM, smem, acc);
  const int w = otid() >> 6, lane = otid() & 63, l15 = lane & 15, lg = lane >> 4;
  const int f0 = ntile * 128 + (w >> 1) * 64 + 4 * lg;
  const int tok0 = mtile * 128 + (w & 1) * 64 + l15;
#pragma unroll
  for (int nt = 0; nt < 4; ++nt)
#pragma unroll
    for (int mt = 0; mt < 4; ++mt) {
      const size_t off = (size_t)(tok0 + 16 * nt) * DM + f0 + 16 * mt;
      const float4 xv = *(const float4*)(P.x + off);
      float4 r; r.x = xv.x + acc[mt][nt][0]; r.y = xv.y + acc[mt][nt][1]; r.z = xv.z + acc[mt][nt][2]; r.w = xv.w + acc[mt][nt][3];
      *(float4*)(P.out + off) = r;
    }
}

__global__ void __launch_bounds__(256, 2) fwd_megakernel(Params P) {
  cg::grid_group grid = cg::this_grid();
  __shared__ __attribute__((aligned(16))) unsigned char smem[73728];
  __shared__ int s_item;
  const int tid = threadIdx.x;
  const int nblk = gridDim.x;
  int* counter = (int*)(P.ws + OFF_CNT);

  if (blockIdx.x == 0 && tid == 0) *counter = 0;
  {
    constexpr int NROWIT = (NTOK + NMEMTOK) / 4;
    constexpr int TOTAL0 = NROWIT + P0_NT + 128;
    for (int it = blockIdx.x; it < TOTAL0; it += nblk) {
      if (it < P0_NT) p0_transpose_item(P, it, smem);
      else if (it < P0_NT + 128) p0_bias_item(P, it - P0_NT, smem);
      else p0_row_norm(P, (it - P0_NT - 128) * 4 + (tid >> 6));
    }
  }
  grid.sync();
  {
    constexpr int NIN = 512 * 23;
    for (int it = blockIdx.x; it < NIN + 64; it += nblk) {
      if (it < NIN) p1_inproj_item(P, it, smem);
      else p1_memkv_item(P, it - NIN, smem);
    }
  }
  grid.sync();
#if EN_NSA && EN_CMP
  for (int it = blockIdx.x; it < 256; it += nblk) p2_compress_item(P, it);
#endif
  grid.sync();
  {
    constexpr int N_NSA = 4096, N_MEM = 2048, N_POOL = 1024;
    for (;;) {
      __syncthreads();
      if (tid == 0) s_item = atomicAdd(counter, 1);
      __syncthreads();
      const int it = s_item;
      if (it >= N_NSA + N_MEM + N_POOL) break;
      if (it < N_NSA) {
#if EN_NSA
        p3_nsa_item(P, it, smem);
#else
        { const int bg = it & 15, qt = it >> 4; const int tok0 = (bg >> 1) * SEQ + qt * 32; if ((bg & 1) == 0 && (qt & 1) == 0) p3_zero_y(P, tok0, 0, 512); }
#endif
      } else if (it < N_NSA + N_MEM) {
#if EN_MEM
        p3_mem_item(P, it - N_NSA, smem);
#else
        { const int i2 = it - N_NSA; if ((i2 & 1) == 0 && ((i2 >> 6) & 3) == 0) { const int tok0 = (i2 >> 8) * SEQ + (i2 & 63) * 128; p3_zero_y(P, tok0, 768, 256); p3_zero_y(P, tok0 + 64, 768, 256);} }
#endif
      } else {
#if EN_POOL
        p3_pool_item(P, it - N_NSA - N_MEM, smem);
#else
        p3_zero_y(P, (it - N_NSA - N_MEM) * 64, 512, 256);
#endif
      }
    }
  }
  grid.sync();
  for (int it = blockIdx.x; it < 4096; it += nblk) p4_outproj_item(P, it, smem);
}

extern "C" void kernel_launch(void* const* d_in, const int* in_sizes, int n_in,
                              void* d_out, int out_size, void* d_ws, size_t ws_size,
                              hipStream_t stream) {
  static int grid_blocks = 0;
  if (!grid_blocks) {
    int dev = 0, cus = 0, per_cu = 0;
    (void)hipGetDevice(&dev);
    (void)hipDeviceGetAttribute(&cus, hipDeviceAttributeMultiprocessorCount, dev);
    (void)hipOccupancyMaxActiveBlocksPerMultiprocessor(&per_cu, fwd_megakernel, 256, 0);
    if (per_cu > 2) per_cu = 2;
    if (per_cu < 1) per_cu = 1;
    grid_blocks = cus * per_cu;
  }
  if (ws_size < WS_NEED) { fprintf(stderr, "workspace too small: %zu < %zu\n", ws_size, (size_t)WS_NEED); return; }
  Params p{};
  p.x = (const float*)d_in[0]; p.mem = (const float*)d_in[1]; p.pos = (const int*)d_in[2];
  p.g_norm = (const float*)d_in[3]; p.w_in = (const float*)d_in[4]; p.g_q_nsa = (const float*)d_in[5];
  p.g_k_cmp = (const float*)d_in[6]; p.g_k_slc = (const float*)d_in[7]; p.g_k_win = (const float*)d_in[8];
  p.cmp_pos_k = (const float*)d_in[9]; p.w_cmp_k1 = (const float*)d_in[10]; p.w_cmp_k2 = (const float*)d_in[11];
  p.cmp_pos_v = (const float*)d_in[12]; p.w_cmp_v1 = (const float*)d_in[13]; p.w_cmp_v2 = (const float*)d_in[14];
  p.w_pool = (const float*)d_in[15]; p.pool_scale = (const float*)d_in[16]; p.g_mem = (const float*)d_in[17];
  p.w_mem_kv = (const float*)d_in[18]; p.g_q_mem = (const float*)d_in[19]; p.g_k_mem = (const float*)d_in[20];
  p.w_out = (const float*)d_in[21];
  p.out = (float*)d_out;
  p.ws = (unsigned char*)d_ws;
  void* args[] = {&p};
  hipError_t e = hipLaunchCooperativeKernel((void*)fwd_megakernel, dim3(grid_blocks), dim3(256), args, 0, stream);
  if (e != hipSuccess) fprintf(stderr, "cooperative launch failed: %s (grid %d)\n", hipGetErrorString(e), grid_blocks);
}
```

```cpp
#include <hip/hip_runtime.h>
#include <hip/hip_cooperative_groups.h>
#include <cstdio>
namespace cg = cooperative_groups;

#define DI __device__ __forceinline__
typedef unsigned short bf16_t;
typedef short bf16x8 __attribute__((ext_vector_type(8)));
typedef short s16x4 __attribute__((ext_vector_type(4)));
typedef float f32x4 __attribute__((ext_vector_type(4)));

#ifndef EN_POOL
#define EN_POOL 1
#endif
#ifndef EN_MEM
#define EN_MEM 1
#endif
#ifndef EN_NSA
#define EN_NSA 1
#endif
#ifndef EN_CMP
#define EN_CMP 1
#endif
#ifndef EN_SEL
#define EN_SEL 1
#endif
#ifndef EN_WIN
#define EN_WIN 1
#endif

constexpr int SEQ = 8192;
constexpr int NB = 8;
constexpr int NTOK = NB * SEQ;
constexpr int DM = 1024;
constexpr int INW = 2840;
constexpr int NFP = 2944;
constexpr int MEML = 256;
constexpr int NMEMTOK = NB * MEML;
constexpr int NCP = 512;

constexpr size_t al256(size_t x) { return (x + 255) & ~(size_t)255; }
constexpr size_t OFF_XB    = 0;
constexpr size_t OFF_WTIN  = OFF_XB    + al256((size_t)NTOK * DM * 2);
constexpr size_t OFF_WTOUT = OFF_WTIN  + al256((size_t)NFP * DM * 2);
constexpr size_t OFF_MH    = OFF_WTOUT + al256((size_t)DM * DM * 2);
constexpr size_t OFF_WTMKV = OFF_MH    + al256((size_t)NMEMTOK * DM * 2);
constexpr size_t OFF_WC1K  = OFF_WTMKV + al256((size_t)512 * DM * 2);
constexpr size_t OFF_WC1V  = OFF_WC1K  + al256((size_t)64 * 2048 * 2);
constexpr size_t OFF_WC2K  = OFF_WC1V  + al256((size_t)64 * 2048 * 2);
constexpr size_t OFF_WC2V  = OFF_WC2K  + al256((size_t)64 * 64 * 2);
constexpr size_t OFF_WPOOL = OFF_WC2V  + al256((size_t)64 * 64 * 2);
constexpr size_t OFF_BIASC = OFF_WPOOL + al256((size_t)4 * 64 * 64 * 2);
constexpr size_t OFF_ROPE  = OFF_BIASC + al256((size_t)128 * 4);
constexpr size_t OFF_QN    = OFF_ROPE  + al256((size_t)NTOK * 16 * 4);
constexpr size_t OFF_KCRAW = OFF_QN    + al256((size_t)NTOK * 512 * 2);
constexpr size_t OFF_VCRAW = OFF_KCRAW + al256((size_t)NTOK * 128 * 2);
constexpr size_t OFF_KS    = OFF_VCRAW + al256((size_t)NTOK * 128 * 2);
constexpr size_t OFF_VST   = OFF_KS    + al256((size_t)NTOK * 128 * 2);
constexpr size_t OFF_KW    = OFF_VST   + al256((size_t)NTOK * 128 * 2);
constexpr size_t OFF_VWT   = OFF_KW    + al256((size_t)NTOK * 128 * 2);
constexpr size_t OFF_ZS    = OFF_VWT   + al256((size_t)NTOK * 128 * 2);
constexpr size_t OFF_VP    = OFF_ZS    + al256((size_t)NTOK * 1024 * 2);
constexpr size_t OFF_QM    = OFF_VP    + al256((size_t)NTOK * 256 * 2);
constexpr size_t OFF_GATES = OFF_QM    + al256((size_t)NTOK * 256 * 2);
constexpr size_t OFF_KC    = OFF_GATES + al256((size_t)NTOK * 24 * 4);
constexpr size_t OFF_VCT   = OFF_KC    + al256((size_t)16 * NCP * 64 * 2);
constexpr size_t OFF_MK    = OFF_VCT   + al256((size_t)16 * 64 * NCP * 2);
constexpr size_t OFF_MVT   = OFF_MK    + al256((size_t)32 * MEML * 64 * 2);
constexpr size_t OFF_Y     = OFF_MVT   + al256((size_t)32 * 64 * MEML * 2);
constexpr size_t OFF_CNT   = OFF_Y     + al256((size_t)NTOK * 1024 * 2);
constexpr size_t WS_NEED   = OFF_CNT   + 256;

struct Params {
  const float* x; const float* mem; const int* pos;
  const float* g_norm; const float* w_in; const float* g_q_nsa; const float* g_k_cmp; const float* g_k_slc; const float* g_k_win;
  const float* cmp_pos_k; const float* w_cmp_k1; const float* w_cmp_k2; const float* cmp_pos_v; const float* w_cmp_v1; const float* w_cmp_v2;
  const float* w_pool; const float* pool_scale; const float* g_mem; const float* w_mem_kv; const float* g_q_mem; const float* g_k_mem; const float* w_out;
  float* out;
  unsigned char* ws;
};

DI int otid() { int t = threadIdx.x; asm volatile("" : "+v"(t)); return t; }
DI bf16_t f2bf(float f) { unsigned u = __float_as_uint(f); u += 0x7fffu + ((u >> 16) & 1u); return (bf16_t)(u >> 16); }
DI float bf2f(bf16_t h) { return __uint_as_float(((unsigned)h) << 16); }
typedef __bf16 hwbf2 __attribute__((ext_vector_type(2)));
typedef float f32x2 __attribute__((ext_vector_type(2)));
DI unsigned pack2(float a, float b) { f32x2 v = {a, b}; hwbf2 r = __builtin_convertvector(v, hwbf2); return __builtin_bit_cast(unsigned, r); }
DI float ex2(float x) { return __builtin_amdgcn_exp2f(x); }
DI f32x4 mfma16(bf16x8 a, bf16x8 b, f32x4 c) { return __builtin_amdgcn_mfma_f32_16x16x32_bf16(a, b, c, 0, 0, 0); }
DI float shx(float v, int m) { return __shfl_xor(v, m, 64); }
DI float silu_f(float z) { return z / (1.f + __expf(-z)); }
DI float sigmoid_f(float z) { return 1.f / (1.f + __expf(-z)); }
DI float gelu_tanh(float x) {
  float u = 0.7978845608028654f * (x + 0.044715f * x * x * x);
  float t = 1.f - 2.f / (__expf(2.f * u) + 1.f);
  return 0.5f * x * (1.f + t);
}
DI bf16x8 pack8(f32x4 a, f32x4 b) {
  uint4 p; p.x = pack2(a[0], a[1]); p.y = pack2(a[2], a[3]); p.z = pack2(b[0], b[1]); p.w = pack2(b[2], b[3]);
  return __builtin_bit_cast(bf16x8, p);
}
DI bf16x8 ld16(const void* p) { return *(const bf16x8*)p; }
DI bf16x8 ld8x2(const void* p0, const void* p1) {
  uint2 a = *(const uint2*)p0; uint2 b = *(const uint2*)p1;
  uint4 r; r.x = a.x; r.y = a.y; r.z = b.x; r.w = b.y;
  return __builtin_bit_cast(bf16x8, r);
}
DI void st4bf(bf16_t* dst, float a, float b, float c, float d) {
  uint2 v; v.x = pack2(a, b); v.y = pack2(c, d); *(uint2*)dst = v;
}

DI void p0_row_norm(const Params& P, int row) {
  const int lane = otid() & 63;
  const bool is_x = row < NTOK;
  const float* src = is_x ? (P.x + (size_t)row * DM) : (P.mem + (size_t)(row - NTOK) * DM);
  bf16_t* dst = is_x ? ((bf16_t*)(P.ws + OFF_XB) + (size_t)row * DM) : ((bf16_t*)(P.ws + OFF_MH) + (size_t)(row - NTOK) * DM);
  float4 v[4];
  float ss = 0.f;
#pragma unroll
  for (int u = 0; u < 4; ++u) {
    v[u] = *(const float4*)(src + lane * 4 + 256 * u);
    ss += v[u].x * v[u].x + v[u].y * v[u].y + v[u].z * v[u].z + v[u].w * v[u].w;
  }
#pragma unroll
  for (int m = 32; m >= 1; m >>= 1) ss += shx(ss, m);
  const float rinv = rsqrtf(ss * (1.f / 1024.f) + 1e-6f);
#pragma unroll
  for (int u = 0; u < 4; ++u) st4bf(dst + lane * 4 + 256 * u, v[u].x * rinv, v[u].y * rinv, v[u].z * rinv, v[u].w * rinv);
  if (is_x && lane < 8) {
    float invf = 1.0f;
    if (lane == 1) invf = 0.19392274f; else if (lane == 2) invf = 0.03760603f; else if (lane == 3) invf = 0.0072926646f;
    else if (lane == 4) invf = 0.0014142136f; else if (lane == 5) invf = 0.0002742482f; else if (lane == 6) invf = 5.3182957e-05f;
    else if (lane == 7) invf = 1.0313385e-05f;
    const float ang = (float)P.pos[row] * invf;
    const double a = (double)ang;
    const double k = rint(a * 0.15915494309189535);
    const float r = (float)(a - k * 6.283185307179586);
    float* rt = (float*)(P.ws + OFF_ROPE) + (size_t)row * 16;
    rt[lane] = cosf(r);
    rt[8 + lane] = sinf(r);
  }
}

DI void p0_transpose_tile(const float* src, int src_ld, int k0, int fsrc0, int nvalid, bf16_t* dst, int dst_ld, int fdst0,
                          const float* scale, unsigned char* smem) {
  float* tile = (float*)smem;
  const int tid = otid();
  const int r = tid >> 4, c4 = (tid & 15) * 4;
#pragma unroll
  for (int ps = 0; ps < 4; ++ps) {
    const int k = r + 16 * ps;
    float4 v = make_float4(0.f, 0.f, 0.f, 0.f);
    if (c4 < nvalid) v = *(const float4*)(src + (size_t)(k0 + k) * src_ld + fsrc0 + c4);
    const float sc = scale ? scale[k0 + k] : 1.f;
    tile[(c4 + 0) * 65 + k] = v.x * sc; tile[(c4 + 1) * 65 + k] = v.y * sc;
    tile[(c4 + 2) * 65 + k] = v.z * sc; tile[(c4 + 3) * 65 + k] = v.w * sc;
  }
  __syncthreads();
  const int f = tid >> 2, kc = (tid & 3) * 16;
  bf16_t* d = dst + (size_t)(fdst0 + f) * dst_ld + k0 + kc;
#pragma unroll
  for (int q = 0; q < 4; ++q) st4bf(d + 4 * q, tile[f * 65 + kc + 4 * q], tile[f * 65 + kc + 4 * q + 1], tile[f * 65 + kc + 4 * q + 2], tile[f * 65 + kc + 4 * q + 3]);
  __syncthreads();
}

DI void p0_transpose_item(const Params& P, int t, unsigned char* smem) {
  unsigned char* ws = P.ws;
  bf16_t* wtin = (bf16_t*)(ws + OFF_WTIN);
  if (t < 320) { p0_transpose_tile(P.w_in, INW, (t / 20) * 64, (t % 20) * 64, 64, wtin, DM, (t % 20) * 64, P.g_norm, smem); return; }
  t -= 320;
  if (t < 384) { p0_transpose_tile(P.w_in, INW, (t / 24) * 64, 1304 + (t % 24) * 64, 64, wtin, DM, 1280 + (t % 24) * 64, P.g_norm, smem); return; }
  t -= 384;
  if (t < 32) { const int ft = t & 1; p0_transpose_tile(P.w_in, INW, (t >> 1) * 64, 1280, ft == 0 ? 24 : 0, wtin, DM, 2816 + ft * 64, P.g_norm, smem); return; }
  t -= 32;
  if (t < 256) { p0_transpose_tile(P.w_out, DM, (t >> 4) * 64, (t & 15) * 64, 64, (bf16_t*)(ws + OFF_WTOUT), DM, (t & 15) * 64, nullptr, smem); return; }
  t -= 256;
  if (t < 128) { p0_transpose_tile(P.w_mem_kv, 512, (t >> 3) * 64, (t & 7) * 64, 64, (bf16_t*)(ws + OFF_WTMKV), DM, (t & 7) * 64, P.g_mem, smem); return; }
  t -= 128;
  if (t < 32) { p0_transpose_tile(P.w_cmp_k1, 64, t * 64, 0, 64, (bf16_t*)(ws + OFF_WC1K), 2048, 0, nullptr, smem); return; }
  t -= 32;
  if (t < 32) { p0_transpose_tile(P.w_cmp_v1, 64, t * 64, 0, 64, (bf16_t*)(ws + OFF_WC1V), 2048, 0, nullptr, smem); return; }
  t -= 32;
  if (t == 0) { p0_transpose_tile(P.w_cmp_k2, 64, 0, 0, 64, (bf16_t*)(ws + OFF_WC2K), 64, 0, nullptr, smem); return; }
  if (t == 1) { p0_transpose_tile(P.w_cmp_v2, 64, 0, 0, 64, (bf16_t*)(ws + OFF_WC2V), 64, 0, nullptr, smem); return; }
  t -= 2;
  if (t < 4) { p0_transpose_tile(P.w_pool + (size_t)t * 4096, 64, 0, 0, 64, (bf16_t*)(ws + OFF_WPOOL) + (size_t)t * 4096, 64, 0, nullptr, smem); return; }
}
constexpr int P0_NT = 320 + 384 + 32 + 256 + 128 + 32 + 32 + 2 + 4;

DI void p0_bias_item(const Params& P, int it, unsigned char* smem) {
  const int which = it >> 6, e = it & 63, tid = otid();
  const float* pe = which ? P.cmp_pos_v : P.cmp_pos_k;
  const float* w1 = which ? P.w_cmp_v1 : P.w_cmp_k1;
  float s = 0.f;
  for (int k = tid; k < 2048; k += 256) s += pe[k] * w1[(size_t)k * 64 + e];
#pragma unroll
  for (int m = 32; m >= 1; m >>= 1) s += shx(s, m);
  float* red = (float*)smem;
  __syncthreads();
  if ((tid & 63) == 0) red[tid >> 6] = s;
  __syncthreads();
  if (tid == 0) ((float*)(P.ws + OFF_BIASC))[it] = red[0] + red[1] + red[2] + red[3];
  __syncthreads();
}

DI void gemm_mainloop(const bf16_t* __restrict__ A, const bf16_t* __restrict__ Bm, const int K, unsigned char* smem, f32x4 (&acc)[4][4]) {
  const int tid = otid(), lane = tid & 63, w = tid >> 6, l15 = lane & 15, lg = lane >> 4;
  const int wr = w >> 1, wc = w & 1;
  const int srow = tid >> 3, sc = tid & 7;
  uint4 ra0, ra1, ra2, ra3, rb0, rb1, rb2, rb3;
#pragma unroll
  for (int i = 0; i < 4; ++i)
#pragma unroll
    for (int j = 0; j < 4; ++j) acc[i][j] = (f32x4){0.f, 0.f, 0.f, 0.f};
  const bf16_t* ap = A + (size_t)srow * K + sc * 8;
  const bf16_t* bp = Bm + (size_t)srow * K + sc * 8;
  const int nk = K >> 6;
#define GLOAD(kt) { const bf16_t* a_ = ap + (kt) * 64; const bf16_t* b_ = bp + (kt) * 64; \
    ra0 = *(const uint4*)(a_); ra1 = *(const uint4*)(a_ + (size_t)32 * K); ra2 = *(const uint4*)(a_ + (size_t)64 * K); ra3 = *(const uint4*)(a_ + (size_t)96 * K); \
    rb0 = *(const uint4*)(b_); rb1 = *(const uint4*)(b_ + (size_t)32 * K); rb2 = *(const uint4*)(b_ + (size_t)64 * K); rb3 = *(const uint4*)(b_ + (size_t)96 * K); }
#define SWRITE(buf) { unsigned char* sa_ = smem + (buf) * 36864 + srow * 144 + sc * 16; \
    *(uint4*)(sa_) = ra0; *(uint4*)(sa_ + 32 * 144) = ra1; *(uint4*)(sa_ + 64 * 144) = ra2; *(uint4*)(sa_ + 96 * 144) = ra3; \
    *(uint4*)(sa_ + 18432) = rb0; *(uint4*)(sa_ + 18432 + 32 * 144) = rb1; *(uint4*)(sa_ + 18432 + 64 * 144) = rb2; *(uint4*)(sa_ + 18432 + 96 * 144) = rb3; }
  GLOAD(0);
  SWRITE(0);
  __syncthreads();
#pragma unroll 1
  for (int kt = 0; kt < nk; ++kt) {
    const int buf = kt & 1;
    const bool more = (kt + 1 < nk);
    if (more) GLOAD(kt + 1);
    const unsigned char* sa = smem + buf * 36864 + (64 * wr + l15) * 144 + lg * 16;
    const unsigned char* sb = smem + buf * 36864 + 18432 + (64 * wc + l15) * 144 + lg * 16;
    {
      bf16x8 af[4], bfr[4];
#pragma unroll
      for (int i = 0; i < 4; ++i) { af[i] = ld16(sa + i * 16 * 144); bfr[i] = ld16(sb + i * 16 * 144); }
#pragma unroll
      for (int i = 0; i < 4; ++i)
#pragma unroll
        for (int j = 0; j < 4; ++j) acc[i][j] = mfma16(af[i], bfr[j], acc[i][j]);
    }
    {
      bf16x8 af[4], bfr[4];
#pragma unroll
      for (int i = 0; i < 4; ++i) { af[i] = ld16(sa + i * 16 * 144 + 64); bfr[i] = ld16(sb + i * 16 * 144 + 64); }
      __builtin_amdgcn_sched_barrier(0);
      if (more) SWRITE(buf ^ 1);
      __builtin_amdgcn_sched_barrier(0);
#pragma unroll
      for (int i = 0; i < 4; ++i)
#pragma unroll
        for (int j = 0; j < 4; ++j) acc[i][j] = mfma16(af[i], bfr[j], acc[i][j]);
    }
    __syncthreads();
  }
#undef GLOAD
#undef SWRITE
}

DI void head_norm_rope(f32x4 (&acc)[4][4], const float* gain, const float* ropeT, int tok0, bool rope, float outscale) {
  const int lane = otid() & 63, l15 = lane & 15, lg = lane >> 4;
  float gn[4][4];
#pragma unroll
  for (int mt = 0; mt < 4; ++mt) { float4 g4 = *(const float4*)(gain + 16 * mt + 4 * lg); gn[mt][0] = g4.x; gn[mt][1] = g4.y; gn[mt][2] = g4.z; gn[mt][3] = g4.w; }
#pragma unroll
  for (int nt = 0; nt < 4; ++nt) {
    float ss = 0.f;
#pragma unroll
    for (int mt = 0; mt < 4; ++mt)
#pragma unroll
      for (int i = 0; i < 4; ++i) ss += acc[mt][nt][i] * acc[mt][nt][i];
    ss += shx(ss, 16); ss += shx(ss, 32);
    const float rinv = rsqrtf(ss * (1.f / 64.f) + 1e-6f);
#pragma unroll
    for (int mt = 0; mt < 4; ++mt)
#pragma unroll
      for (int i = 0; i < 4; ++i) acc[mt][nt][i] = acc[mt][nt][i] * rinv * gn[mt][i];
    if (rope) {
      const float* rt = ropeT + (size_t)(tok0 + 16 * nt + l15) * 16 + 4 * (lg & 1);
      const float4 c4 = *(const float4*)rt, s4 = *(const float4*)(rt + 8);
      const float cs[4] = {c4.x, c4.y, c4.z, c4.w}, sn[4] = {s4.x, s4.y, s4.z, s4.w};
#pragma unroll
      for (int i = 0; i < 4; ++i) {
        const float own = acc[0][nt][i];
        const float oth = shx(own, 32);
        acc[0][nt][i] = (lg < 2) ? (own * cs[i] - oth * sn[i]) : (oth * sn[i] + own * cs[i]);
      }
    }
#pragma unroll
    for (int mt = 0; mt < 4; ++mt)
#pragma unroll
      for (int i = 0; i < 4; ++i) acc[mt][nt][i] *= outscale;
  }
}

DI void store_rowmajor(const f32x4 (&acc)[4][4], bf16_t* dst, size_t ld) {
  const int lane = otid() & 63, l15 = lane & 15, lg = lane >> 4;
#pragma unroll
  for (int nt = 0; nt < 4; ++nt)
#pragma unroll
    for (int mt = 0; mt < 4; ++mt)
      st4bf(dst + (size_t)(16 * nt + l15) * ld + 16 * mt + 4 * lg, acc[mt][nt][0], acc[mt][nt][1], acc[mt][nt][2], acc[mt][nt][3]);
}
DI void store_transposed(const f32x4 (&acc)[4][4], bf16_t* dst, size_t ld) {
  const int lane = otid() & 63, l15 = lane & 15, lg = lane >> 4;
#pragma unroll
  for (int nt = 0; nt < 4; ++nt)
#pragma unroll
    for (int mt = 0; mt < 4; ++mt)
#pragma unroll
      for (int i = 0; i < 4; ++i) dst[(size_t)(16 * mt + 4 * lg + i) * ld + 16 * nt + l15] = f2bf(acc[mt][nt][i]);
}

DI void p1_inproj_item(const Params& P, int item, unsigned char* smem) {
  unsigned char* ws = P.ws;
  const int mtile = item / 23, ntile = item % 23;
  f32x4 acc[4][4];
  gemm_mainloop((const bf16_t*)(ws + OFF_WTIN) + (size_t)ntile * 128 * DM, (const bf16_t*)(ws + OFF_XB) + (size_t)mtile * 128 * DM, DM, smem, acc);
  const int w = otid() >> 6, lane = otid() & 63, l15 = lane & 15, lg = lane >> 4;
  const int ft = ntile * 2 + (w >> 1);
  const int tok0 = mtile * 128 + (w & 1) * 64;
  const int b = tok0 >> 13, s0 = tok0 & (SEQ - 1);
  const float* ropeT = (const float*)(ws + OFF_ROPE);
  if (ft < 8) {
    head_norm_rope(acc, P.g_q_nsa, ropeT, tok0, true, 0.18033688011112042f);
    store_rowmajor(acc, (bf16_t*)(ws + OFF_QN) + ((size_t)(b * 8 + ft) * SEQ + s0) * 64, 64);
  } else if (ft < 20) {
    const int idx = (ft - 8) >> 1, gi = (ft - 8) & 1;
    const size_t rm = ((size_t)(b * 2 + gi) * SEQ + s0) * 64;
    const size_t tr = (size_t)(b * 2 + gi) * 64 * SEQ + s0;
    if (idx == 0) store_rowmajor(acc, (bf16_t*)(ws + OFF_KCRAW) + rm, 64);
    else if (idx == 1) store_rowmajor(acc, (bf16_t*)(ws + OFF_VCRAW) + rm, 64);
    else if (idx == 2) { head_norm_rope(acc, P.g_k_slc, ropeT, tok0, true, 1.f); store_rowmajor(acc, (bf16_t*)(ws + OFF_KS) + rm, 64); }
    else if (idx == 3) store_transposed(acc, (bf16_t*)(ws + OFF_VST) + tr, SEQ);
    else if (idx == 4) { head_norm_rope(acc, P.g_k_win, ropeT, tok0, true, 1.f); store_rowmajor(acc, (bf16_t*)(ws + OFF_KW) + rm, 64); }
    else store_transposed(acc, (bf16_t*)(ws + OFF_VWT) + tr, SEQ);
  } else if (ft < 28 || (ft >= 32 && ft < 36) || (ft >= 40 && ft < 44)) {
    const int zoff = (ft < 28) ? (ft - 20) * 64 : (ft < 36 ? 512 + (ft - 32) * 64 : 768 + (ft - 40) * 64);
#pragma unroll
    for (int mt = 0; mt < 4; ++mt)
#pragma unroll
      for (int nt = 0; nt < 4; ++nt)
#pragma unroll
        for (int i = 0; i < 4; ++i) acc[mt][nt][i] = silu_f(acc[mt][nt][i]);
    store_rowmajor(acc, (bf16_t*)(ws + OFF_ZS) + (size_t)tok0 * 1024 + zoff, 1024);
  } else if (ft < 32) {
    store_rowmajor(acc, (bf16_t*)(ws + OFF_VP) + (size_t)tok0 * 256 + (ft - 28) * 64, 256);
  } else if (ft < 40) {
    head_norm_rope(acc, P.g_q_mem, ropeT, tok0, false, 0.18033688011112042f);
    store_rowmajor(acc, (bf16_t*)(ws + OFF_QM) + ((size_t)(b * 4 + (ft - 36)) * SEQ + s0) * 64, 64);
  } else if (ft == 44) {
    float* gt = (float*)(ws + OFF_GATES);
#pragma unroll
    for (int nt = 0; nt < 4; ++nt)
#pragma unroll
      for (int mt = 0; mt < 2; ++mt)
#pragma unroll
        for (int i = 0; i < 4; ++i) {
          const int f = 16 * mt + 4 * lg + i;
          if (f < 24) gt[(size_t)(tok0 + 16 * nt + l15) * 24 + f] = sigmoid_f(acc[mt][nt][i]);
        }
  }
}

DI void p1_memkv_item(const Params& P, int item, unsigned char* smem) {
  unsigned char* ws = P.ws;
  const int mtile = item >> 2, ntile = item & 3;
  f32x4 acc[4][4];
  gemm_mainloop((const bf16_t*)(ws + OFF_WTMKV) + (size_t)ntile * 128 * DM, (const bf16_t*)(ws + OFF_MH) + (size_t)mtile * 128 * DM, DM, smem, acc);
  const int w = otid() >> 6;
  const int ft = ntile * 2 + (w >> 1);
  const int tok0 = mtile * 128 + (w & 1) * 64;
  const int b = tok0 >> 8, m0 = tok0 & 255;
  if (ft < 4) {
    head_norm_rope(acc, P.g_k_mem, nullptr, 0, false, 1.f);
    store_rowmajor(acc, (bf16_t*)(ws + OFF_MK) + ((size_t)(b * 4 + ft) * MEML + m0) * 64, 64);
  } else {
    store_transposed(acc, (bf16_t*)(ws + OFF_MVT) + (size_t)(b * 4 + (ft - 4)) * 64 * MEML + m0, MEML);
  }
}

DI void p2_compress_item(const Params& P, int item) {
  unsigned char* ws = P.ws;
  const int which = item >> 7, bg = (item >> 3) & 15, ntile = item & 7;
  const int tid = otid(), lane = tid & 63, w = tid >> 6, l15 = lane & 15, lg = lane >> 4;
  const int n = ntile * 64 + w * 16 + l15;
  const int nc = n < 511 ? n : 510;
  const bf16_t* raw = (const bf16_t*)(ws + (which ? OFF_VCRAW : OFF_KCRAW)) + ((size_t)bg * SEQ + 16 * nc) * 64 + 8 * lg;
  const bf16_t* w1 = (const bf16_t*)(ws + (which ? OFF_WC1V : OFF_WC1K)) + (size_t)l15 * 2048 + 8 * lg;
  f32x4 acc[4];
#pragma unroll
  for (int i = 0; i < 4; ++i) acc[i] = (f32x4){0.f, 0.f, 0.f, 0.f};
#pragma unroll 4
  for (int ks = 0; ks < 64; ++ks) {
    const bf16x8 bq = ld16(raw + ks * 32);
#pragma unroll
    for (int mt = 0; mt < 4; ++mt) acc[mt] = mfma16(ld16(w1 + (size_t)mt * 16 * 2048 + ks * 32), bq, acc[mt]);
  }
  const float* bias = (const float*)(ws + OFF_BIASC) + which * 64;
#pragma unroll
  for (int mt = 0; mt < 4; ++mt)
#pragma unroll
    for (int i = 0; i < 4; ++i) acc[mt][i] = gelu_tanh(acc[mt][i] + bias[16 * mt + 4 * lg + i]);
  const bf16_t* w2 = (const bf16_t*)(ws + (which ? OFF_WC2V : OFF_WC2K)) + (size_t)l15 * 64 + 4 * lg;
  f32x4 a2[4];
#pragma unroll
  for (int i = 0; i < 4; ++i) a2[i] = (f32x4){0.f, 0.f, 0.f, 0.f};
#pragma unroll
  for (int ks2 = 0; ks2 < 2; ++ks2) {
    const bf16x8 hb = pack8(acc[2 * ks2], acc[2 * ks2 + 1]);
#pragma unroll
    for (int ft = 0; ft < 4; ++ft) {
      const bf16_t* wp = w2 + (size_t)ft * 16 * 64 + 32 * ks2;
      a2[ft] = mfma16(ld8x2(wp, wp + 16), hb, a2[ft]);
    }
  }
  const int b = bg >> 1;
  if (which == 0) {
    float ss = 0.f;
#pragma unroll
    for (int ft = 0; ft < 4; ++ft)
#pragma unroll
      for (int i = 0; i < 4; ++i) ss += a2[ft][i] * a2[ft][i];
    ss += shx(ss, 16); ss += shx(ss, 32);
    const float rinv = rsqrtf(ss * (1.f / 64.f) + 1e-6f);
#pragma unroll
    for (int ft = 0; ft < 4; ++ft) {
      const float4 g4 = *(const float4*)(P.g_k_cmp + 16 * ft + 4 * lg);
      a2[ft][0] *= rinv * g4.x; a2[ft][1] *= rinv * g4.y; a2[ft][2] *= rinv * g4.z; a2[ft][3] *= rinv * g4.w;
    }
    const float* rt = (const float*)(ws + OFF_ROPE) + ((size_t)b * SEQ + 16 * nc + 31) * 16 + 4 * (lg & 1);
    const float4 c4 = *(const float4*)rt, s4 = *(const float4*)(rt + 8);
    const float cs[4] = {c4.x, c4.y, c4.z, c4.w}, sn[4] = {s4.x, s4.y, s4.z, s4.w};
#pragma unroll
    for (int i = 0; i < 4; ++i) {
      const float own = a2[0][i];
      const float oth = shx(own, 32);
      a2[0][i] = (lg < 2) ? (own * cs[i] - oth * sn[i]) : (oth * sn[i] + own * cs[i]);
    }
    bf16_t* dst = (bf16_t*)(ws + OFF_KC) + ((size_t)bg * NCP + n) * 64 + 4 * lg;
    const float z = (n < 511) ? 1.f : 0.f;
#pragma unroll
    for (int ft = 0; ft < 4; ++ft) st4bf(dst + 16 * ft, a2[ft][0] * z, a2[ft][1] * z, a2[ft][2] * z, a2[ft][3] * z);
  } else {
    bf16_t* dst = (bf16_t*)(ws + OFF_VCT) + (size_t)bg * 64 * NCP + n;
    const float z = (n < 511) ? 1.f : 0.f;
#pragma unroll
    for (int ft = 0; ft < 4; ++ft)
#pragma unroll
      for (int i = 0; i < 4; ++i) dst[(size_t)(16 * ft + 4 * lg + i) * NCP] = f2bf(a2[ft][i] * z);
  }
}

enum { M_WIN = 0, M_SEL = 1, M_MEM = 2, M_CMPA = 3, M_CMPB = 4 };
constexpr int SM_IMP = 36864;
constexpr int SM_SEL = SM_IMP + 32 * 129 * 4;

template <int MODE>
DI void attn_run(const bf16_t* __restrict__ kbase, const bf16_t* __restrict__ vbase, const int vstride,
                 const int tile_begin, const int tile_end,
                 const bf16x8 (&qf)[2][2], const int (&tq)[2], const int (&tokl)[2],
                 f32x4 (&o)[2][4], float (&m)[2], float (&l)[2], unsigned char* smem, const int tmin) {
  if (tile_begin >= tile_end) return;
  const int tid = otid(), lane = tid & 63, l15 = lane & 15, lg = lane >> 4;
  const int srow = tid >> 3, sc = tid & 7;
  uint4 rk0, rk1, rv0 = make_uint4(0,0,0,0), rv1 = make_uint4(0,0,0,0);
  const unsigned short* selbits = (const unsigned short*)(smem + SM_SEL);
  float* imp = (float*)(smem + SM_IMP);
#define AGLOAD(t) { const bf16_t* k_ = kbase + ((size_t)((t) * 64 + srow)) * 64 + sc * 8; rk0 = *(const uint4*)(k_); rk1 = *(const uint4*)(k_ + 32 * 64); \
      if (MODE != M_CMPA) { const bf16_t* v_ = vbase + (size_t)srow * vstride + (t) * 64 + sc * 8; rv0 = *(const uint4*)(v_); rv1 = *(const uint4*)(v_ + (size_t)32 * vstride); } }
#define ASWRITE(buf) { unsigned char* d_ = smem + (buf) * 9216 + srow * 144 + sc * 16; *(uint4*)(d_) = rk0; *(uint4*)(d_ + 32 * 144) = rk1; \
      if (MODE != M_CMPA) { *(uint4*)(d_ + 18432) = rv0; *(uint4*)(d_ + 18432 + 32 * 144) = rv1; } }
  AGLOAD(tile_begin);
  ASWRITE(0);
  __syncthreads();
#pragma unroll 1
  for (int t = tile_begin; t < tile_end; ++t) {
    const int buf = (t - tile_begin) & 1;
    const bool more = (t + 1 < tile_end);
    if (more) AGLOAD(t + 1);
    const unsigned char* ck = smem + buf * 9216 + l15 * 144 + lg * 16;
    const unsigned char* cv = smem + 18432 + buf * 9216 + l15 * 144 + lg * 8;
    bool bit[2] = {true, true};
    bool need = true;
    if (MODE == M_SEL) {
#pragma unroll
      for (int c = 0; c < 2; ++c) bit[c] = (selbits[tokl[c] * 8 + (t >> 4)] >> (t & 15)) & 1;
      need = __any(bit[0] || bit[1]) != 0;
    }
    if (need) {
      f32x4 s[2][4];
#pragma unroll
      for (int c = 0; c < 2; ++c)
#pragma unroll
        for (int kt = 0; kt < 4; ++kt) s[c][kt] = (f32x4){0.f, 0.f, 0.f, 0.f};
#pragma unroll
      for (int ks = 0; ks < 2; ++ks)
#pragma unroll
        for (int kt = 0; kt < 4; ++kt) {
          const bf16x8 a = ld16(ck + kt * 16 * 144 + ks * 64);
          s[0][kt] = mfma16(a, qf[0][ks], s[0][kt]);
          s[1][kt] = mfma16(a, qf[1][ks], s[1][kt]);
        }
      bool needmask = false;
      if (MODE == M_WIN) needmask = (t * 64 + 63 > tmin) || (t * 64 <= tmin + 7 - 512);
      if (MODE == M_SEL) needmask = (t * 64 + 63 > tmin);
      if (MODE == M_CMPA || MODE == M_CMPB) needmask = (16 * (t * 64 + 63) + 31 > tmin);
      if (needmask) {
        const int key0 = t * 64 + 4 * lg;
#pragma unroll
        for (int c = 0; c < 2; ++c)
#pragma unroll
          for (int kt = 0; kt < 4; ++kt)
#pragma unroll
            for (int i = 0; i < 4; ++i) {
              const int kk = key0 + 16 * kt + i;
              bool ok = true;
              if (MODE == M_WIN) ok = (kk <= tq[c]) && (kk > tq[c] - 512);
              if (MODE == M_SEL) ok = (kk <= tq[c]);
              if (MODE == M_CMPA || MODE == M_CMPB) ok = (16 * kk + 31 <= tq[c]);
              s[c][kt][i] = ok ? s[c][kt][i] : -__builtin_inff();
            }
      }
      bf16x8 pf[2][2];
#pragma unroll
      for (int c = 0; c < 2; ++c) {
        float msub, scl = 1.f;
        if (MODE == M_CMPB) {
          msub = (m[c] == -__builtin_inff()) ? 0.f : m[c];
          scl = l[c];
        } else {
          float mx = fmaxf(fmaxf(s[c][0][0], s[c][0][1]), fmaxf(s[c][0][2], s[c][0][3]));
#pragma unroll
          for (int kt = 1; kt < 4; ++kt) mx = fmaxf(mx, fmaxf(fmaxf(s[c][kt][0], s[c][kt][1]), fmaxf(s[c][kt][2], s[c][kt][3])));
          if (MODE == M_SEL) mx = bit[c] ? mx : -__builtin_inff();
          if (__any(mx > m[c] + 8.f)) {
            mx = fmaxf(mx, shx(mx, 16)); mx = fmaxf(mx, shx(mx, 32));
            const float mnew = fmaxf(m[c], mx);
            const float ms = (mnew == -__builtin_inff()) ? 0.f : mnew;
            const float alpha = ex2(m[c] - ms);
            m[c] = mnew;
            l[c] *= alpha;
            if (MODE != M_CMPA) {
#pragma unroll
              for (int dt = 0; dt < 4; ++dt) o[c][dt] *= alpha;
            }
          }
          msub = (m[c] == -__builtin_inff()) ? 0.f : m[c];
          if (MODE == M_SEL) msub = bit[c] ? msub : __builtin_inff();
        }
        float psum = 0.f;
#pragma unroll
        for (int kt = 0; kt < 4; ++kt)
#pragma unroll
          for (int i = 0; i < 4; ++i) {
            float p = ex2(s[c][kt][i] - msub);
            if (MODE == M_CMPB) p *= scl;
            s[c][kt][i] = p;
            psum += p;
          }
        if (MODE != M_CMPB) l[c] += psum;
        if (MODE == M_CMPB) {
          const int key0 = t * 64 + 4 * lg;
#pragma unroll
          for (int kt = 0; kt < 4; ++kt) {
            float pa = s[c][kt][0] + s[c][kt][1] + s[c][kt][2] + 0.5f * s[c][kt][3];
            float pb = 0.5f * s[c][kt][3];
            pa += shx(pa, 1); pa += shx(pa, 2);
            pb += shx(pb, 1); pb += shx(pb, 2);
            if ((lane & 3) == 0) {
              const int j = (key0 + 16 * kt) >> 2;
              atomicAdd(&imp[tokl[c] * 129 + j], pa);
              if (j + 1 < 128) atomicAdd(&imp[tokl[c] * 129 + j + 1], pb);
            }
          }
        }
        if (MODE != M_CMPA) {
          pf[c][0] = pack8(s[c][0], s[c][1]);
          pf[c][1] = pack8(s[c][2], s[c][3]);
        }
      }
      if (MODE != M_CMPA) {
#pragma unroll
        for (int ks2 = 0; ks2 < 2; ++ks2)
#pragma unroll
          for (int dt = 0; dt < 4; ++dt) {
            const unsigned char* vp = cv + dt * 16 * 144 + ks2 * 64;
            const bf16x8 a = ld8x2(vp, vp + 32);
            o[0][dt] = mfma16(a, pf[0][ks2], o[0][dt]);
            o[1][dt] = mfma16(a, pf[1][ks2], o[1][dt]);
          }
      }
    }
    if (more) ASWRITE(buf ^ 1);
    __syncthreads();
  }
#undef AGLOAD
#undef ASWRITE
}

DI void attn_reset(f32x4 (&o)[2][4], float (&m)[2], float (&l)[2]) {
#pragma unroll
  for (int c = 0; c < 2; ++c) {
    m[c] = -__builtin_inff(); l[c] = 0.f;
#pragma unroll
    for (int dt = 0; dt < 4; ++dt) o[c][dt] = (f32x4){0.f, 0.f, 0.f, 0.f};
  }
}
DI void attn_accum(f32x4 (&ot)[2][4], const f32x4 (&o)[2][4], const float (&l)[2], const float (&gate)[2]) {
#pragma unroll
  for (int c = 0; c < 2; ++c) {
    float lt = l[c]; lt += shx(lt, 16); lt += shx(lt, 32);
    const float f = gate[c] / fmaxf(lt, 1.17549435e-38f);
#pragma unroll
    for (int dt = 0; dt < 4; ++dt) ot[c][dt] += o[c][dt] * f;
  }
}

DI void topk_select(unsigned char* smem, int cur) {
  const int tid = otid(), lane = tid & 63, tok = tid >> 3, sub = tid & 7;
  const float* imp = (const float*)(smem + SM_IMP);
  unsigned short* selbits = (unsigned short*)(smem + SM_SEL);
  unsigned bits = 0;
  if (cur <= 15) {
#pragma unroll
    for (int q = 0; q < 16; ++q) if (16 * sub + q <= cur) bits |= 1u << q;
  } else {
    unsigned key[16];
#pragma unroll
    for (int q = 0; q < 16; ++q) {
      const int j = 16 * sub + q;
      const bool cand = (j >= 1) && (j <= cur - 2);
      key[q] = cand ? (__float_as_uint(imp[tok * 129 + j]) + 1u) : 0u;
    }
    unsigned T = 0;
#pragma unroll 1
    for (int b = 31; b >= 0; --b) {
      const unsigned cnd = T | (1u << b);
      int cnt = 0;
#pragma unroll
      for (int q = 0; q < 16; ++q) cnt += (key[q] >= cnd) ? 1 : 0;
      cnt += __shfl_xor(cnt, 1, 64); cnt += __shfl_xor(cnt, 2, 64); cnt += __shfl_xor(cnt, 4, 64);
      if (cnt >= 13) T = cnd;
    }
    int cgt = 0, ceq = 0;
#pragma unroll
    for (int q = 0; q < 16; ++q) { cgt += (key[q] > T) ? 1 : 0; ceq += (key[q] == T) ? 1 : 0; }
    int gt_tot = cgt;
    gt_tot += __shfl_xor(gt_tot, 1, 64); gt_tot += __shfl_xor(gt_tot, 2, 64); gt_tot += __shfl_xor(gt_tot, 4, 64);
    int pre = 0;
#pragma unroll
    for (int k = 0; k < 8; ++k) { const int v = __shfl(ceq, (lane & ~7) | k, 64); if (k < sub) pre += v; }
    const int quota = 13 - gt_tot;
#pragma unroll
    for (int q = 0; q < 16; ++q) {
      if (key[q] > T) bits |= 1u << q;
      else if (key[q] == T && T != 0u) { if (pre < quota) bits |= 1u << q; ++pre; }
    }
    if (sub == 0) bits |= 1u;
    if ((cur >> 4) == sub) bits |= 1u << (cur & 15);
    if (((cur - 1) >> 4) == sub) bits |= 1u << ((cur - 1) & 15);
  }
  selbits[tok * 8 + sub] = (unsigned short)bits;
}

DI void p3_nsa_item(const Params& P, int item, unsigned char* smem) {
  unsigned char* ws = P.ws;
  const int bg = item & 15, qt = 255 - (item >> 4);
  const int b = bg >> 1, gi = bg & 1, t0 = qt * 32, cur = qt >> 1;
  const int tid = otid(), lane = tid & 63, w = tid >> 6, l15 = lane & 15, lg = lane >> 4;
  int tokl[2], tq[2];
  bf16x8 qf[2][2];
  float gt[3][2];
  const int tmin = __builtin_amdgcn_readfirstlane(t0 + 8 * w);
  const int head = 4 * gi + (l15 & 3);
#pragma unroll
  for (int c = 0; c < 2; ++c) {
    tokl[c] = 8 * w + 4 * c + (l15 >> 2);
    tq[c] = t0 + tokl[c];
    const bf16_t* qp = (const bf16_t*)(ws + OFF_QN) + ((size_t)(b * 8 + head) * SEQ + tq[c]) * 64 + 8 * lg;
    qf[c][0] = ld16(qp); qf[c][1] = ld16(qp + 32);
    const float* gp = (const float*)(ws + OFF_GATES) + (size_t)(b * SEQ + tq[c]) * 24 + head * 3;
    gt[0][c] = gp[0]; gt[1][c] = gp[1]; gt[2][c] = gp[2];
  }
  f32x4 ot[2][4], o[2][4];
  float m[2], l[2];
#pragma unroll
  for (int c = 0; c < 2; ++c)
#pragma unroll
    for (int dt = 0; dt < 4; ++dt) ot[c][dt] = (f32x4){0.f, 0.f, 0.f, 0.f};
  float* imp = (float*)(smem + SM_IMP);
  for (int i = tid; i < 32 * 129; i += 256) imp[i] = 0.f;
  const bf16_t* kc = (const bf16_t*)(ws + OFF_KC) + (size_t)bg * NCP * 64;
  const bf16_t* vct = (const bf16_t*)(ws + OFF_VCT) + (size_t)bg * 64 * NCP;
  const int ctiles = (qt >> 5) + 1;
#if EN_CMP
  attn_reset(o, m, l);
  attn_run<M_CMPA>(kc, vct, NCP, 0, ctiles, qf, tq, tokl, o, m, l, smem, tmin);
#pragma unroll
  for (int c = 0; c < 2; ++c) { float lt = l[c]; lt += shx(lt, 16); lt += shx(lt, 32); l[c] = 1.f / fmaxf(lt, 1.17549435e-38f); }
  attn_run<M_CMPB>(kc, vct, NCP, 0, ctiles, qf, tq, tokl, o, m, l, smem, tmin);
#pragma unroll
  for (int c = 0; c < 2; ++c)
#pragma unroll
    for (int dt = 0; dt < 4; ++dt) ot[c][dt] += o[c][dt] * gt[0][c];
#else
  __syncthreads();
#endif
  topk_select(smem, cur);
  __syncthreads();
#if EN_SEL
  attn_reset(o, m, l);
  attn_run<M_SEL>((const bf16_t*)(ws + OFF_KS) + (size_t)bg * SEQ * 64, (const bf16_t*)(ws + OFF_VST) + (size_t)bg * 64 * SEQ, SEQ,
                  0, cur + 1, qf, tq, tokl, o, m, l, smem, tmin);
  attn_accum(ot, o, l, gt[1]);
#endif
#if EN_WIN
  attn_reset(o, m, l);
  attn_run<M_WIN>((const bf16_t*)(ws + OFF_KW) + (size_t)bg * SEQ * 64, (const bf16_t*)(ws + OFF_VWT) + (size_t)bg * 64 * SEQ, SEQ,
                  (t0 >= 511) ? ((t0 - 511) >> 6) : 0, cur + 1, qf, tq, tokl, o, m, l, smem, tmin);
  attn_accum(ot, o, l, gt[2]);
#endif
#pragma unroll
  for (int c = 0; c < 2; ++c) {
    const size_t off = (size_t)(b * SEQ + tq[c]) * 1024 + head * 64 + 4 * lg;
    const bf16_t* zp = (const bf16_t*)(ws + OFF_ZS) + off;
    bf16_t* yp = (bf16_t*)(ws + OFF_Y) + off;
#pragma unroll
    for (int dt = 0; dt < 4; ++dt) {
      const uint2 zz = *(const uint2*)(zp + 16 * dt);
      st4bf(yp + 16 * dt, ot[c][dt][0] * bf2f((bf16_t)(zz.x & 0xffff)), ot[c][dt][1] * bf2f((bf16_t)(zz.x >> 16)),
            ot[c][dt][2] * bf2f((bf16_t)(zz.y & 0xffff)), ot[c][dt][3] * bf2f((bf16_t)(zz.y >> 16)));
    }
  }
}

DI void p3_mem_item(const Params& P, int item, unsigned char* smem) {
  unsigned char* ws = P.ws;
  const int bh = item >> 6, qt = item & 63;
  const int b = bh >> 2, h = bh & 3, t0 = qt * 128;
  const int tid = otid(), lane = tid & 63, w = tid >> 6, l15 = lane & 15, lg = lane >> 4;
  int tokl[2], tq[2];
  bf16x8 qf[2][2];
  const int tmin = 0;
#pragma unroll
  for (int c = 0; c < 2; ++c) {
    tokl[c] = 0;
    tq[c] = t0 + 32 * w + 16 * c + l15;
    const bf16_t* qp = (const bf16_t*)(ws + OFF_QM) + ((size_t)bh * SEQ + tq[c]) * 64 + 8 * lg;
    qf[c][0] = ld16(qp); qf[c][1] = ld16(qp + 32);
  }
  f32x4 o[2][4];
  float m[2], l[2];
  attn_reset(o, m, l);
  attn_run<M_MEM>((const bf16_t*)(ws + OFF_MK) + (size_t)bh * MEML * 64, (const bf16_t*)(ws + OFF_MVT) + (size_t)bh * 64 * MEML, MEML,
                  0, 4, qf, tq, tokl, o, m, l, smem, tmin);
#pragma unroll
  for (int c = 0; c < 2; ++c) {
    float lt = l[c]; lt += shx(lt, 16); lt += shx(lt, 32);
    const float f = 1.f / fmaxf(lt, 1.17549435e-38f);
    const size_t off = (size_t)(b * SEQ + tq[c]) * 1024 + 768 + h * 64 + 4 * lg;
    const bf16_t* zp = (const bf16_t*)(ws + OFF_ZS) + off;
    bf16_t* yp = (bf16_t*)(ws + OFF_Y) + off;
#pragma unroll
    for (int dt = 0; dt < 4; ++dt) {
      const uint2 zz = *(const uint2*)(zp + 16 * dt);
      st4bf(yp + 16 * dt, o[c][dt][0] * f * bf2f((bf16_t)(zz.x & 0xffff)), o[c][dt][1] * f * bf2f((bf16_t)(zz.x >> 16)),
            o[c][dt][2] * f * bf2f((bf16_t)(zz.y & 0xffff)), o[c][dt][3] * f * bf2f((bf16_t)(zz.y >> 16)));
    }
  }
}

DI void p3_pool_item(const Params& P, int item, unsigned char* smem) {
  unsigned char* ws = P.ws;
  const int tok0 = item * 64, s0 = tok0 & (SEQ - 1);
  const int tid = otid(), lane = tid & 63, w = tid >> 6, l15 = lane & 15, lg = lane >> 4;
  const bf16_t* vp = (const bf16_t*)(ws + OFF_VP);
  for (int q = tid; q < 79 * 32; q += 256) {
    const int r = q >> 5, cch = q & 31;
    const int s = s0 - 15 + r;
    uint4 v = make_uint4(0, 0, 0, 0);
    if (s >= 0) v = *(const uint4*)(vp + (size_t)(tok0 - 15 + r) * 256 + cch * 8);
    *(uint4*)(smem + r * 528 + cch * 16) = v;
  }
  __syncthreads();
  const int rown = 15 + 16 * w + l15;
  const int s = s0 + 16 * w + l15;
  const int tok = tok0 + 16 * w + l15;
#pragma unroll
  for (int gp = 0; gp < 4; ++gp) {
    const int win = 2 << gp;
    const float rc = 1.f / (float)((s + 1 < win) ? (s + 1) : win);
    f32x4 acc[4];
#pragma unroll
    for (int i = 0; i < 4; ++i) acc[i] = (f32x4){0.f, 0.f, 0.f, 0.f};
#pragma unroll
    for (int ks = 0; ks < 2; ++ks) {
      const int cb = (gp * 64 + 32 * ks + 8 * lg) * 2;
      float sum[8];
#pragma unroll
      for (int j = 0; j < 8; ++j) sum[j] = 0.f;
      uint4 own = make_uint4(0, 0, 0, 0);
      for (int i = 0; i < win; ++i) {
        const uint4 v = *(const uint4*)(smem + (rown - i) * 528 + cb);
        if (i == 0) own = v;
        sum[0] += bf2f((bf16_t)(v.x & 0xffff)); sum[1] += bf2f((bf16_t)(v.x >> 16));
        sum[2] += bf2f((bf16_t)(v.y & 0xffff)); sum[3] += bf2f((bf16_t)(v.y >> 16));
        sum[4] += bf2f((bf16_t)(v.z & 0xffff)); sum[5] += bf2f((bf16_t)(v.z >> 16));
        sum[6] += bf2f((bf16_t)(v.w & 0xffff)); sum[7] += bf2f((bf16_t)(v.w >> 16));
      }
      uint4 pk;
      pk.x = pack2(sum[0] * rc - bf2f((bf16_t)(own.x & 0xffff)), sum[1] * rc - bf2f((bf16_t)(own.x >> 16)));
      pk.y = pack2(sum[2] * rc - bf2f((bf16_t)(own.y & 0xffff)), sum[3] * rc - bf2f((bf16_t)(own.y >> 16)));
      pk.z = pack2(sum[4] * rc - bf2f((bf16_t)(own.z & 0xffff)), sum[5] * rc - bf2f((bf16_t)(own.z >> 16)));
      pk.w = pack2(sum[6] * rc - bf2f((bf16_t)(own.w & 0xffff)), sum[7] * rc - bf2f((bf16_t)(own.w >> 16)));
      const bf16x8 bq = __builtin_bit_cast(bf16x8, pk);
      const bf16_t* wp = (const bf16_t*)(ws + OFF_WPOOL) + (size_t)gp * 4096 + (size_t)l15 * 64 + 32 * ks + 8 * lg;
#pragma unroll
      for (int mt = 0; mt < 4; ++mt) acc[mt] = mfma16(ld16(wp + mt * 16 * 64), bq, acc[mt]);
    }
    const size_t off = (size_t)tok * 1024 + 512 + gp * 64 + 4 * lg;
    const bf16_t* zp = (const bf16_t*)(ws + OFF_ZS) + off;
    bf16_t* yp = (bf16_t*)(ws + OFF_Y) + off;
#pragma unroll
    for (int mt = 0; mt < 4; ++mt) {
      const float4 ps = *(const float4*)(P.pool_scale + gp * 64 + 16 * mt + 4 * lg);
      const uint2 zz = *(const uint2*)(zp + 16 * mt);
      st4bf(yp + 16 * mt, acc[mt][0] * ps.x * bf2f((bf16_t)(zz.x & 0xffff)), acc[mt][1] * ps.y * bf2f((bf16_t)(zz.x >> 16)),
            acc[mt][2] * ps.z * bf2f((bf16_t)(zz.y & 0xffff)), acc[mt][3] * ps.w * bf2f((bf16_t)(zz.y >> 16)));
    }
  }
  __syncthreads();
}

DI void p3_zero_y(const Params& P, int tok0, int col0, int ncol) {
  bf16_t* y = (bf16_t*)(P.ws + OFF_Y);
  const int per_row = ncol / 8;
  for (int q = otid(); q < 64 * per_row; q += 256) {
    const int r = q / per_row, cch = q % per_row;
    *(uint4*)(y + (size_t)(tok0 + r) * 1024 + col0 + cch * 8) = make_uint4(0, 0, 0, 0);
  }
}

DI void p4_outproj_item(const Params& P, int item, unsigned char* smem) {
  unsigned char* ws = P.ws;
  const int mtile = item >> 3, ntile = item & 7;
  f32x4 acc[4][4];
  gemm_mainloop((const bf16_t*)(ws + OFF_WTOUT) + (size_t)ntile * 128 * DM, (const bf16_t*)(ws + OFF_Y) + (size_t)mtile * 128 * DM, DM, smem, acc);
  const int w = otid() >> 6, lane = otid() & 63, l15 = lane & 15, lg = lane >> 4;
  const int f0 = ntile * 128 + (w >> 1) * 64 + 4 * lg;
  const int tok0 = mtile * 128 + (w & 1) * 64 + l15;
#pragma unroll
  for (int nt = 0; nt < 4; ++nt)
#pragma unroll
    for (int mt = 0; mt < 4; ++mt) {
      const size_t off = (size_t)(tok0 + 16 * nt) * DM + f0 + 16 * mt;
      const float4 xv = *(const float4*)(P.x + off);
      float4 r; r.x = xv.x + acc[mt][nt][0]; r.y = xv.y + acc[mt][nt][1]; r.z = xv.z + acc[mt][nt][2]; r.w = xv.w + acc[mt][nt][3];
      *(float4*)(P.out + off) = r;
    }
}

__global__ void __launch_bounds__(256, 2) fwd_megakernel(Params P) {
  cg::grid_group grid = cg::this_grid();
  __shared__ __attribute__((aligned(16))) unsigned char smem[73728];
  __shared__ int s_item;
  const int tid = threadIdx.x;
  const int nblk = gridDim.x;
  int* counter = (int*)(P.ws + OFF_CNT);

  if (blockIdx.x == 0 && tid == 0) { counter[0] = 0; counter[1] = 0; }
  {
    constexpr int NROWIT = (NTOK + NMEMTOK) / 4;
    constexpr int TOTAL0 = NROWIT + P0_NT + 128;
    for (int it = blockIdx.x; it < TOTAL0; it += nblk) {
      if (it < P0_NT) p0_transpose_item(P, it, smem);
      else if (it < P0_NT + 128) p0_bias_item(P, it - P0_NT, smem);
      else p0_row_norm(P, (it - P0_NT - 128) * 4 + (tid >> 6));
    }
  }
  grid.sync();
#ifndef DUP_P1
#define DUP_P1 1
#endif
#ifndef DUP_P3
#define DUP_P3 1
#endif
#ifndef DUP_P4
#define DUP_P4 1
#endif
  for (int rep = 0; rep < DUP_P1; ++rep) {
    constexpr int NIN = 512 * 23;
    for (int it = blockIdx.x; it < NIN + 64; it += nblk) {
      if (it < NIN) p1_inproj_item(P, it, smem);
      else p1_memkv_item(P, it - NIN, smem);
    }
  }
  grid.sync();
#if EN_NSA && EN_CMP
  for (int it = blockIdx.x; it < 256; it += nblk) p2_compress_item(P, it);
#endif
  grid.sync();
  for (int rep = 0; rep < DUP_P3; ++rep) {
    if (rep) { grid.sync(); counter += 1; }
    constexpr int N_NSA = 4096, N_MEM = 2048, N_POOL = 1024;
    for (;;) {
      __syncthreads();
      if (tid == 0) s_item = atomicAdd(counter, 1);
      __syncthreads();
      const int it = s_item;
      if (it >= N_NSA + N_MEM + N_POOL) break;
      if (it < N_NSA) {
#if EN_NSA
        p3_nsa_item(P, it, smem);
#else
        { const int bg = it & 15, qt = it >> 4; const int tok0 = (bg >> 1) * SEQ + qt * 32; if ((bg & 1) == 0 && (qt & 1) == 0) p3_zero_y(P, tok0, 0, 512); }
#endif
      } else if (it < N_NSA + N_MEM) {
#if EN_MEM
        p3_mem_item(P, it - N_NSA, smem);
#else
        { const int i2 = it - N_NSA; if ((i2 & 1) == 0 && ((i2 >> 6) & 3) == 0) { const int tok0 = (i2 >> 8) * SEQ + (i2 & 63) * 128; p3_zero_y(P, tok0, 768, 256); p3_zero_y(P, tok0 + 64, 768, 256);} }
#endif
      } else {
#if EN_POOL
        p3_pool_item(P, it - N_NSA - N_MEM, smem);
#else
        p3_zero_y(P, (it - N_NSA - N_MEM) * 64, 512, 256);
#endif
      }
    }
  }
  grid.sync();
  for (int rep = 0; rep < DUP_P4; ++rep)
  for (int it = blockIdx.x; it < 4096; it += nblk) p4_outproj_item(P, it, smem);
}

extern "C" void kernel_launch(void* const* d_in, const int* in_sizes, int n_in,
                              void* d_out, int out_size, void* d_ws, size_t ws_size,
                              hipStream_t stream) {
  static int grid_blocks = 0;
  if (!grid_blocks) {
    int dev = 0, cus = 0, per_cu = 0;
    (void)hipGetDevice(&dev);
    (void)hipDeviceGetAttribute(&cus, hipDeviceAttributeMultiprocessorCount, dev);
    (void)hipOccupancyMaxActiveBlocksPerMultiprocessor(&per_cu, fwd_megakernel, 256, 0);
    if (per_cu > 2) per_cu = 2;
    if (per_cu < 1) per_cu = 1;
    grid_blocks = cus * per_cu;
  }
  if (ws_size < WS_NEED) { fprintf(stderr, "workspace too small: %zu < %zu\n", ws_size, (size_t)WS_NEED); return; }
  Params p{};
  p.x = (const float*)d_in[0]; p.mem = (const float*)d_in[1]; p.pos = (const int*)d_in[2];
  p.g_norm = (const float*)d_in[3]; p.w_in = (const float*)d_in[4]; p.g_q_nsa = (const float*)d_in[5];
  p.g_k_cmp = (const float*)d_in[6]; p.g_k_slc = (const float*)d_in[7]; p.g_k_win = (const float*)d_in[8];
  p.cmp_pos_k = (const float*)d_in[9]; p.w_cmp_k1 = (const float*)d_in[10]; p.w_cmp_k2 = (const float*)d_in[11];
  p.cmp_pos_v = (const float*)d_in[12]; p.w_cmp_v1 = (const float*)d_in[13]; p.w_cmp_v2 = (const float*)d_in[14];
  p.w_pool = (const float*)d_in[15]; p.pool_scale = (const float*)d_in[16]; p.g_mem = (const float*)d_in[17];
  p.w_mem_kv = (const float*)d_in[18]; p.g_q_mem = (const float*)d_in[19]; p.g_k_mem = (const float*)d_in[20];
  p.w_out = (const float*)d_in[21];
  p.out = (float*)d_out;
  p.ws = (unsigned char*)d_ws;
  void* args[] = {&p};
  hipError_t e = hipLaunchCooperativeKernel((void*)fwd_megakernel, dim3(grid_blocks), dim3(256), args, 0, stream);
  if (e != hipSuccess) fprintf(stderr, "cooperative launch failed: %s (grid %d)\n", hipGetErrorString(e), grid_blocks);
}
```

```cpp
#include <hip/hip_runtime.h>
#include <hip/hip_cooperative_groups.h>
#include <cstdio>
namespace cg = cooperative_groups;

#define DI __device__ __forceinline__
typedef unsigned short bf16_t;
typedef short bf16x8 __attribute__((ext_vector_type(8)));
typedef short s16x4 __attribute__((ext_vector_type(4)));
typedef float f32x4 __attribute__((ext_vector_type(4)));

#ifndef EN_POOL
#define EN_POOL 1
#endif
#ifndef EN_MEM
#define EN_MEM 1
#endif
#ifndef EN_NSA
#define EN_NSA 1
#endif
#ifndef EN_CMP
#define EN_CMP 1
#endif
#ifndef EN_SEL
#define EN_SEL 1
#endif
#ifndef EN_WIN
#define EN_WIN 1
#endif

constexpr int SEQ = 8192;
constexpr int NB = 8;
constexpr int NTOK = NB * SEQ;
constexpr int DM = 1024;
constexpr int INW = 2840;
constexpr int NFP = 3072;
constexpr int MEML = 256;
constexpr int NMEMTOK = NB * MEML;
constexpr int NCP = 512;

constexpr size_t al256(size_t x) { return (x + 255) & ~(size_t)255; }
constexpr size_t OFF_XB    = 0;
constexpr size_t OFF_WTIN  = OFF_XB    + al256((size_t)NTOK * DM * 2);
constexpr size_t OFF_WTOUT = OFF_WTIN  + al256((size_t)NFP * DM * 2);
constexpr size_t OFF_MH    = OFF_WTOUT + al256((size_t)DM * DM * 2);
constexpr size_t OFF_WTMKV = OFF_MH    + al256((size_t)NMEMTOK * DM * 2);
constexpr size_t OFF_WC1K  = OFF_WTMKV + al256((size_t)512 * DM * 2);
constexpr size_t OFF_WC1V  = OFF_WC1K  + al256((size_t)64 * 2048 * 2);
constexpr size_t OFF_WC2K  = OFF_WC1V  + al256((size_t)64 * 2048 * 2);
constexpr size_t OFF_WC2V  = OFF_WC2K  + al256((size_t)64 * 64 * 2);
constexpr size_t OFF_WPOOL = OFF_WC2V  + al256((size_t)64 * 64 * 2);
constexpr size_t OFF_BIASC = OFF_WPOOL + al256((size_t)4 * 64 * 64 * 2);
constexpr size_t OFF_ROPE  = OFF_BIASC + al256((size_t)128 * 4);
constexpr size_t OFF_QN    = OFF_ROPE  + al256((size_t)NTOK * 16 * 4);
constexpr size_t OFF_KCRAW = OFF_QN    + al256((size_t)NTOK * 512 * 2);
constexpr size_t OFF_VCRAW = OFF_KCRAW + al256((size_t)NTOK * 128 * 2);
constexpr size_t OFF_KS    = OFF_VCRAW + al256((size_t)NTOK * 128 * 2);
constexpr size_t OFF_VST   = OFF_KS    + al256((size_t)NTOK * 128 * 2);
constexpr size_t OFF_KW    = OFF_VST   + al256((size_t)NTOK * 128 * 2);
constexpr size_t OFF_VWT   = OFF_KW    + al256((size_t)NTOK * 128 * 2);
constexpr size_t OFF_ZS    = OFF_VWT   + al256((size_t)NTOK * 128 * 2);
constexpr size_t OFF_VP    = OFF_ZS    + al256((size_t)NTOK * 1024 * 2);
constexpr size_t OFF_QM    = OFF_VP    + al256((size_t)NTOK * 256 * 2);
constexpr size_t OFF_GATES = OFF_QM    + al256((size_t)NTOK * 256 * 2);
constexpr size_t OFF_KC    = OFF_GATES + al256((size_t)NTOK * 24 * 4);
constexpr size_t OFF_VCT   = OFF_KC    + al256((size_t)16 * NCP * 64 * 2);
constexpr size_t OFF_MK    = OFF_VCT   + al256((size_t)16 * 64 * NCP * 2);
constexpr size_t OFF_MVT   = OFF_MK    + al256((size_t)32 * MEML * 64 * 2);
constexpr size_t OFF_Y     = OFF_MVT   + al256((size_t)32 * 64 * MEML * 2);
constexpr size_t OFF_CNT   = OFF_Y     + al256((size_t)NTOK * 1024 * 2);
constexpr size_t WS_NEED   = OFF_CNT   + 512;

struct Params {
  const float* x; const float* mem; const int* pos;
  const float* g_norm; const float* w_in; const float* g_q_nsa; const float* g_k_cmp; const float* g_k_slc; const float* g_k_win;
  const float* cmp_pos_k; const float* w_cmp_k1; const float* w_cmp_k2; const float* cmp_pos_v; const float* w_cmp_v1; const float* w_cmp_v2;
  const float* w_pool; const float* pool_scale; const float* g_mem; const float* w_mem_kv; const float* g_q_mem; const float* g_k_mem; const float* w_out;
  float* out;
  unsigned char* ws;
};

DI float4 ntload4(const float* p) { f32x4 v = __builtin_nontemporal_load((const f32x4*)p); return make_float4(v[0], v[1], v[2], v[3]); }
DI void ntstore4(float* p, float4 r) { f32x4 v = {r.x, r.y, r.z, r.w}; __builtin_nontemporal_store(v, (f32x4*)p); }
DI int otid() { int t = threadIdx.x; asm volatile("" : "+v"(t)); return t; }
DI bf16_t f2bf(float f) { unsigned u = __float_as_uint(f); u += 0x7fffu + ((u >> 16) & 1u); return (bf16_t)(u >> 16); }
DI float bf2f(bf16_t h) { return __uint_as_float(((unsigned)h) << 16); }
typedef __bf16 hwbf2 __attribute__((ext_vector_type(2)));
typedef float f32x2 __attribute__((ext_vector_type(2)));
DI unsigned pack2(float a, float b) { f32x2 v = {a, b}; hwbf2 r = __builtin_convertvector(v, hwbf2); return __builtin_bit_cast(unsigned, r); }
DI float ex2(float x) { return __builtin_amdgcn_exp2f(x); }
DI f32x4 mfma16(bf16x8 a, bf16x8 b, f32x4 c) { return __builtin_amdgcn_mfma_f32_16x16x32_bf16(a, b, c, 0, 0, 0); }
DI float shx(float v, int m) { return __shfl_xor(v, m, 64); }
#define DPP_I(v, ctrl) __builtin_amdgcn_update_dpp(0, (v), (ctrl), 0xF, 0xF, false)
DI int   dpp_x1(int v)   { return DPP_I(v, 0xB1); }
DI int   dpp_x2(int v)   { return DPP_I(v, 0x4E); }
DI int   dpp_hm(int v)   { return DPP_I(v, 0x141); }
DI float dpp_x1f(float v) { return __builtin_bit_cast(float, dpp_x1(__builtin_bit_cast(int, v))); }
DI float dpp_x2f(float v) { return __builtin_bit_cast(float, dpp_x2(__builtin_bit_cast(int, v))); }
DI float silu_f(float z) { return z * __builtin_amdgcn_rcpf(1.f + __builtin_amdgcn_exp2f(-1.4426950408889634f * z)); }
DI float sigmoid_f(float z) { return __builtin_amdgcn_rcpf(1.f + __builtin_amdgcn_exp2f(-1.4426950408889634f * z)); }
DI float gelu_tanh(float x) {
  float u = 0.7978845608028654f * (x + 0.044715f * x * x * x);
  float t = 1.f - 2.f * __builtin_amdgcn_rcpf(__builtin_amdgcn_exp2f(2.8853900817779268f * u) + 1.f);
  return 0.5f * x * (1.f + t);
}
DI bf16x8 pack8(f32x4 a, f32x4 b) {
  uint4 p; p.x = pack2(a[0], a[1]); p.y = pack2(a[2], a[3]); p.z = pack2(b[0], b[1]); p.w = pack2(b[2], b[3]);
  return __builtin_bit_cast(bf16x8, p);
}
DI bf16x8 ld16(const void* p) { return *(const bf16x8*)p; }
DI bf16x8 ld8x2(const void* p0, const void* p1) {
  uint2 a = *(const uint2*)p0; uint2 b = *(const uint2*)p1;
  uint4 r; r.x = a.x; r.y = a.y; r.z = b.x; r.w = b.y;
  return __builtin_bit_cast(bf16x8, r);
}
DI void st4bf(bf16_t* dst, float a, float b, float c, float d) {
  uint2 v; v.x = pack2(a, b); v.y = pack2(c, d); *(uint2*)dst = v;
}

DI void p0_row_norm(const Params& P, int row) {
  const int lane = otid() & 63;
  const bool is_x = row < NTOK;
  const float* src = is_x ? (P.x + (size_t)row * DM) : (P.mem + (size_t)(row - NTOK) * DM);
  bf16_t* dst = is_x ? ((bf16_t*)(P.ws + OFF_XB) + (size_t)row * DM) : ((bf16_t*)(P.ws + OFF_MH) + (size_t)(row - NTOK) * DM);
  float4 v[4];
  float ss = 0.f;
#pragma unroll
  for (int u = 0; u < 4; ++u) {
    v[u] = *(const float4*)(src + lane * 4 + 256 * u);
    ss += v[u].x * v[u].x + v[u].y * v[u].y + v[u].z * v[u].z + v[u].w * v[u].w;
  }
#pragma unroll
  for (int m = 32; m >= 1; m >>= 1) ss += shx(ss, m);
  const float rinv = rsqrtf(ss * (1.f / 1024.f) + 1e-6f);
#pragma unroll
  for (int u = 0; u < 4; ++u) st4bf(dst + lane * 4 + 256 * u, v[u].x * rinv, v[u].y * rinv, v[u].z * rinv, v[u].w * rinv);
  if (is_x && lane < 8) {
    float invf = 1.0f;
    if (lane == 1) invf = 0.19392274f; else if (lane == 2) invf = 0.03760603f; else if (lane == 3) invf = 0.0072926646f;
    else if (lane == 4) invf = 0.0014142136f; else if (lane == 5) invf = 0.0002742482f; else if (lane == 6) invf = 5.3182957e-05f;
    else if (lane == 7) invf = 1.0313385e-05f;
    const float ang = (float)P.pos[row] * invf;
    const double a = (double)ang;
    const double k = rint(a * 0.15915494309189535);
    const float r = (float)(a - k * 6.283185307179586);
    float* rt = (float*)(P.ws + OFF_ROPE) + (size_t)row * 16;
    rt[lane] = cosf(r);
    rt[8 + lane] = sinf(r);
  }
}

DI void p0_row_norm2(const Params& P, int row) {
  const int lane = otid() & 63;
  const bool is_x = row < NTOK;
  const float* src = is_x ? (P.x + (size_t)row * DM) : (P.mem + (size_t)(row - NTOK) * DM);
  bf16_t* dst = is_x ? ((bf16_t*)(P.ws + OFF_XB) + (size_t)row * DM) : ((bf16_t*)(P.ws + OFF_MH) + (size_t)(row - NTOK) * DM);
  float4 v[4][4];
#pragma unroll
  for (int r = 0; r < 4; ++r)
#pragma unroll
    for (int u = 0; u < 4; ++u) v[r][u] = ntload4(src + r * DM + lane * 4 + 256 * u);
#pragma unroll
  for (int r = 0; r < 4; ++r) {
    float ss = 0.f;
#pragma unroll
    for (int u = 0; u < 4; ++u) ss += v[r][u].x * v[r][u].x + v[r][u].y * v[r][u].y + v[r][u].z * v[r][u].z + v[r][u].w * v[r][u].w;
#pragma unroll
    for (int m = 32; m >= 1; m >>= 1) ss += shx(ss, m);
    const float rinv = rsqrtf(ss * (1.f / 1024.f) + 1e-6f);
#pragma unroll
    for (int u = 0; u < 4; ++u) st4bf(dst + r * DM + lane * 4 + 256 * u, v[r][u].x * rinv, v[r][u].y * rinv, v[r][u].z * rinv, v[r][u].w * rinv);
  }
  if (is_x && lane < 32) {
    const int fi = lane & 7, rr = row + (lane >> 3);
    float invf = 1.0f;
    if (fi == 1) invf = 0.19392274f; else if (fi == 2) invf = 0.03760603f; else if (fi == 3) invf = 0.0072926646f;
    else if (fi == 4) invf = 0.0014142136f; else if (fi == 5) invf = 0.0002742482f; else if (fi == 6) invf = 5.3182957e-05f;
    else if (fi == 7) invf = 1.0313385e-05f;
    const float ang = (float)P.pos[rr] * invf;
    const double a = (double)ang;
    const double k = rint(a * 0.15915494309189535);
    const float r = (float)(a - k * 6.283185307179586);
    float* rt = (float*)(P.ws + OFF_ROPE) + (size_t)rr * 16;
    rt[fi] = cosf(r);
    rt[8 + fi] = sinf(r);
  }
}

struct TrJob { const float* src; int src_ld, k0, fsrc0, nvalid; bf16_t* dst; int dst_ld, fdst0; const float* scale; int split; };
DI void p0_transpose_tile(const TrJob& j, bool valid, int tid, unsigned char* smem) {
  float* tile = (float*)smem;
  const int r = tid >> 4, c4 = (tid & 15) * 4;
  if (valid) {
#pragma unroll
    for (int ps = 0; ps < 4; ++ps) {
      const int k = r + 16 * ps;
      float4 v = make_float4(0.f, 0.f, 0.f, 0.f);
      if (c4 < j.nvalid) v = *(const float4*)(j.src + (size_t)(j.k0 + k) * j.src_ld + j.fsrc0 + c4);
      const float sc = j.scale ? j.scale[j.k0 + k] : 1.f;
      tile[(c4 + 0) * 65 + k] = v.x * sc; tile[(c4 + 1) * 65 + k] = v.y * sc;
      tile[(c4 + 2) * 65 + k] = v.z * sc; tile[(c4 + 3) * 65 + k] = v.w * sc;
    }
  }
  __syncthreads();
  if (valid) {
    const int f = tid >> 2, kc = (tid & 3) * 16;
    const int row = j.split ? (j.fdst0 + (f & 31) + 128 * (f >> 5)) : (j.fdst0 + f);
    bf16_t* d = j.dst + (size_t)row * j.dst_ld + j.k0 + kc;
#pragma unroll
    for (int q = 0; q < 4; ++q) st4bf(d + 4 * q, tile[f * 65 + kc + 4 * q], tile[f * 65 + kc + 4 * q + 1], tile[f * 65 + kc + 4 * q + 2], tile[f * 65 + kc + 4 * q + 3]);
  }
  __syncthreads();
}
constexpr int P0_NT = 768 + 256 + 128 + 32 + 32 + 2 + 4;

DI TrJob p0_job(const Params& P, int t) {
  unsigned char* ws = P.ws;
  TrJob j{};
  j.src_ld = 64; j.nvalid = 64; j.dst_ld = 64;
  if (t < 768) {
    const int ft = t % 48, kt = t / 48;
    j.src = P.w_in; j.src_ld = INW; j.k0 = kt * 64; j.scale = P.g_norm; j.dst = (bf16_t*)(ws + OFF_WTIN); j.dst_ld = DM; j.split = 1;
    j.fdst0 = (ft >> 2) * 256 + (ft & 3) * 32;
    if (ft < 20) j.fsrc0 = ft * 64; else if (ft < 44) j.fsrc0 = 1304 + (ft - 20) * 64; else { j.fsrc0 = 1280; j.nvalid = (ft == 44) ? 24 : 0; }
    return j;
  }
  t -= 768;
  if (t < 256) { j.src = P.w_out; j.src_ld = DM; j.k0 = (t >> 4) * 64; j.fsrc0 = (t & 15) * 64; j.dst = (bf16_t*)(ws + OFF_WTOUT); j.dst_ld = DM; j.fdst0 = (t & 15) * 64; return j; }
  t -= 256;
  if (t < 128) { const int ft = t & 7; j.src = P.w_mem_kv; j.src_ld = 512; j.k0 = (t >> 3) * 64; j.fsrc0 = ft * 64; j.scale = P.g_mem; j.dst = (bf16_t*)(ws + OFF_WTMKV); j.dst_ld = DM;
                 j.split = 1; j.fdst0 = (ft >> 2) * 256 + (ft & 3) * 32; return j; }
  t -= 128;
  if (t < 32) { j.src = P.w_cmp_k1; j.k0 = t * 64; j.dst = (bf16_t*)(ws + OFF_WC1K); j.dst_ld = 2048; return j; }
  t -= 32;
  if (t < 32) { j.src = P.w_cmp_v1; j.k0 = t * 64; j.dst = (bf16_t*)(ws + OFF_WC1V); j.dst_ld = 2048; return j; }
  t -= 32;
  if (t == 0) { j.src = P.w_cmp_k2; j.dst = (bf16_t*)(ws + OFF_WC2K); return j; }
  if (t == 1) { j.src = P.w_cmp_v2; j.dst = (bf16_t*)(ws + OFF_WC2V); return j; }
  t -= 2;
  j.src = P.w_pool + (size_t)t * 4096; j.dst = (bf16_t*)(ws + OFF_WPOOL) + (size_t)t * 4096;
  return j;
}
DI void p0_transpose_pair(const Params& P, int it, unsigned char* smem) {
  const int tid = otid(), half = tid >> 8;
  const int t = 2 * it + half;
  const bool valid = t < P0_NT;
  const TrJob j = p0_job(P, valid ? t : 0);
  p0_transpose_tile(j, valid, tid & 255, smem + half * 17408);
}

DI void p0_bias_pair(const Params& P, int it2, unsigned char* smem) {
  const int tid0 = otid(), half = tid0 >> 8, tid = tid0 & 255, it = 2 * it2 + half;
  const int which = it >> 6, e = it & 63;
  const float* pe = which ? P.cmp_pos_v : P.cmp_pos_k;
  const float* w1 = which ? P.w_cmp_v1 : P.w_cmp_k1;
  float s = 0.f;
  for (int k = tid; k < 2048; k += 256) s += pe[k] * w1[(size_t)k * 64 + e];
#pragma unroll
  for (int m = 32; m >= 1; m >>= 1) s += shx(s, m);
  float* red = (float*)smem + half * 8;
  __syncthreads();
  if ((tid & 63) == 0) red[tid >> 6] = s;
  __syncthreads();
  if (tid == 0) ((float*)(P.ws + OFF_BIASC))[it] = red[0] + red[1] + red[2] + red[3];
  __syncthreads();
}

namespace pg8 {
#define PG8_LAS __attribute__((address_space(3)))
typedef unsigned short bf16_t;
typedef short bf16x8 __attribute__((ext_vector_type(8)));
typedef float f32x4 __attribute__((ext_vector_type(4)));
typedef unsigned u32x4 __attribute__((ext_vector_type(4)));
constexpr int BM = 256, BK = 64, HALF = 128, HTB = HALF * BK * 2  , STAGE_BYTES = 8 * HTB, NXCD = 8, WGM = 8;

__host__ __device__ __forceinline__ int lds_byte(int r, int c) { const int st = (r >> 4) * 2 + (c >> 5), rr = r & 15, cc = c & 31, ob = rr * 64 + cc * 2; return st * 1024 + (ob ^ (((ob >> 9) & 1) << 5)); }
__host__ __device__ __forceinline__ void stage_rc(int b, int& R, int& C) { const int st = b / 1024, sb = b % 1024, swz = sb ^ (((sb >> 9) & 1) << 5); R = (st >> 1) * 16 + swz / 64; C = (st & 1) * 32 + (swz % 64) / 2; }
__host__ __device__ __forceinline__ int perm32(int rho) { const int n = rho >> 4, i = rho & 15; return 8 * (i >> 2) + 4 * n + (i & 3); }

struct Unit { int pm, pn; };
struct Gemm { const bf16_t* A; const bf16_t* Bt; int M, N, K; };

struct StaticOrder {
    int nM, nN, nwg, G, c;
    __host__ __device__ void init(int M, int N, int G_, int c_) { nM = M / BM; nN = N / BM; nwg = nM * nN; G = G_; c = c_; }
    __host__ __device__ bool next(int i, Unit& u) const {
        const long L = (long)i * G + c; if (L >= nwg) return false;
        int wgid = (int)L; { const int q = nwg / NXCD, r = nwg % NXCD, xcd = wgid % NXCD, off = wgid / NXCD; wgid = (xcd < r ? xcd * (q + 1) : r * (q + 1) + (xcd - r) * q) + off; }
        const int nig = WGM * nN, gid = wgid / nig, fm = gid * WGM, gsz = (nM - fm) < WGM ? (nM - fm) : WGM;
        u.pm = fm + ((wgid % nig) % gsz); u.pn = (wgid % nig) / gsz; return true;
    }
    __device__ __forceinline__ void a_ready(const Unit&) const {}
    __device__ __forceinline__ void done(const Unit&) const {}
};
template <class Epi, class Sched, bool STAMP = false>
__device__ __forceinline__ void gemm_phase(PG8_LAS unsigned char* lds, const Gemm g, const Sched& S, const Epi& E, unsigned long long* stamps) {
    const int tid = otid(), wid = __builtin_amdgcn_readfirstlane(tid >> 6), lane = tid & 63, wr = wid >> 2, wc = wid & 3, fr = lane & 15, fq = lane >> 4;
    const int K = g.K, nt = K / BK;
    int ts_lo = 0, ts_hi = 0, nts = 0; const unsigned long long rt_entry = STAMP ? (unsigned long long)wall_clock64() : 0ull;
#define PG8_STAMP() do { if (STAMP && wid == 0 && nts < 64) { const unsigned long long _c = (unsigned long long)clock64(); \
        ts_lo = (lane == nts) ? (int)(unsigned)_c : ts_lo; ts_hi = (lane == nts) ? (int)(unsigned)(_c >> 32) : ts_hi; ++nts; } } while (0)
    PG8_STAMP();
    unsigned voffA[2], voffB[2];
#pragma unroll
    for (int i = 0; i < 2; ++i) { int R, C; stage_rc(tid * 16 + i * 8192, R, C); const int Rb = Epi::PERM ? ((R & ~31) + perm32(R & 31)) : R;
        voffA[i] = (unsigned)(R * K + C) * 2u; voffB[i] = (unsigned)(Rb * K + C) * 2u; }
    const size_t kstep = (size_t)(BK * 2);
    const size_t hstep = (size_t)HALF * K * 2;
    const size_t tstep = 2 * hstep;
    const unsigned ldsw = (unsigned)wid * 1024u;
    const int aoff = lds_byte(wr * 64 + fr, fq * 8), boff = lds_byte(wc * 32 + fr, fq * 8);
#define PG8_SA(b, h) (((b) * 2 + (h)) * HTB)
#define PG8_SB(b, h) ((4 + (b) * 2 + (h)) * HTB)
#define PG8_STAGE(bufoff, gbase, voff) do { _Pragma("unroll") for (int _i = 0; _i < 2; ++_i) \
        __builtin_amdgcn_global_load_lds((const unsigned*)((const char*)(gbase) + (voff)[_i]), (PG8_LAS unsigned*)(lds + (bufoff) + ldsw + _i * 8192), 16, 0, 0); } while (0)
#define PG8_LDA(dst, b, h) do { _Pragma("unroll") for (int m = 0; m < 4; ++m) _Pragma("unroll") for (int k = 0; k < 2; ++k) dst[m][k] = *(const PG8_LAS bf16x8*)(lds + PG8_SA(b, h) + aoff + m * 2048 + k * 1024); } while (0)
#define PG8_LDB(dst, b, h) do { _Pragma("unroll") for (int n = 0; n < 2; ++n) _Pragma("unroll") for (int k = 0; k < 2; ++k) dst[n][k] = *(const PG8_LAS bf16x8*)(lds + PG8_SB(b, h) + boff + n * 2048 + k * 1024); } while (0)
#define PG8_MMA(ai, bj, At, Bt) do { __builtin_amdgcn_s_setprio(1); _Pragma("unroll") for (int m = 0; m < 4; ++m) _Pragma("unroll") for (int n = 0; n < 2; ++n) _Pragma("unroll") for (int k = 0; k < 2; ++k) \
        acc[ai][bj][m][n] = __builtin_amdgcn_mfma_f32_16x16x32_bf16(Bt[n][k], At[m][k], acc[ai][bj][m][n], 0, 0, 0); __builtin_amdgcn_s_setprio(0); } while (0)
#define PG8_WAIT_V(n) asm volatile("s_waitcnt vmcnt(" #n ")" ::: "memory")
#define PG8_WAIT_L(n) asm volatile("s_waitcnt lgkmcnt(" #n ")" ::: "memory")
#define PG8_BAR __builtin_amdgcn_s_barrier()
#define PG8_SCHED __builtin_amdgcn_sched_barrier(0)
    Unit cur, nxt; int ui = 0;
    if (!S.next(0, cur)) return;
    f32x4 acc[2][2][4][2];
#pragma unroll
    for (int a = 0; a < 2; ++a)
#pragma unroll
        for (int b = 0; b < 2; ++b)
#pragma unroll
            for (int m = 0; m < 4; ++m)
#pragma unroll
                for (int n = 0; n < 2; ++n) acc[a][b][m][n] = (f32x4){0.f, 0.f, 0.f, 0.f};
    bf16x8 At[4][2], B0[2][2], B1[2][2];
    const char* cA = (const char*)g.A + (size_t)cur.pm * tstep; const char* cB = (const char*)g.Bt + (size_t)cur.pn * tstep;
    S.a_ready(cur);
    PG8_STAGE(PG8_SB(0, 0), cB, voffB); PG8_STAGE(PG8_SA(0, 0), cA, voffA); PG8_STAGE(PG8_SB(0, 1), cB + hstep, voffB); PG8_STAGE(PG8_SA(0, 1), cA + hstep, voffA);
    if (wr == 1) PG8_BAR;
    PG8_WAIT_V(4); PG8_BAR;
    PG8_STAGE(PG8_SB(1, 0), cB + kstep, voffB); PG8_STAGE(PG8_SA(1, 0), cA + kstep, voffA); PG8_STAGE(PG8_SB(1, 1), cB + hstep + kstep, voffB);
    PG8_WAIT_V(6); PG8_BAR;
    PG8_STAMP();
    for (;;) {
        const bool has_next = S.next(ui + 1, nxt);
        const char* nA = has_next ? (const char*)g.A + (size_t)nxt.pm * tstep : cA; const char* nB = has_next ? (const char*)g.Bt + (size_t)nxt.pn * tstep : cB;
        for (int t = 0; t < nt; t += 2) {
            const bool last = (t == nt - 2);
            const char* a1 = cA + (size_t)(t + 1) * kstep;
            const char* a2 = last ? nA : cA + (size_t)(t + 2) * kstep; const char* b2 = last ? nB : cB + (size_t)(t + 2) * kstep;
            const char* a3 = a2 + kstep; const char* b3 = b2 + kstep;
            if (last && has_next) S.a_ready(nxt);
            PG8_LDB(B0, 0, 0); PG8_SCHED; PG8_LDA(At, 0, 0); PG8_STAGE(PG8_SA(1, 1), a1 + hstep, voffA);
            PG8_WAIT_L(8); PG8_BAR; PG8_WAIT_L(0); PG8_MMA(0, 0, At, B0); PG8_BAR; PG8_SCHED;
            PG8_LDB(B1, 0, 1); PG8_STAGE(PG8_SB(0, 0), b2, voffB);
            PG8_BAR; PG8_WAIT_L(0); PG8_MMA(0, 1, At, B1); PG8_BAR;
            PG8_LDA(At, 0, 1); PG8_STAGE(PG8_SA(0, 0), a2, voffA);
            PG8_BAR; PG8_WAIT_L(0); PG8_MMA(1, 0, At, B0); PG8_BAR; PG8_SCHED;
            PG8_STAGE(PG8_SB(0, 1), b2 + hstep, voffB);
            PG8_WAIT_V(6); PG8_BAR; PG8_MMA(1, 1, At, B1); PG8_BAR;
            PG8_LDB(B0, 1, 0); PG8_SCHED; PG8_LDA(At, 1, 0); PG8_STAGE(PG8_SA(0, 1), a2 + hstep, voffA);
            PG8_WAIT_L(8); PG8_BAR; PG8_WAIT_L(0); PG8_MMA(0, 0, At, B0); PG8_BAR; PG8_SCHED;
            PG8_LDB(B1, 1, 1); PG8_STAGE(PG8_SB(1, 0), b3, voffB);
            PG8_BAR; PG8_WAIT_L(0); PG8_MMA(0, 1, At, B1); PG8_BAR;
            PG8_LDA(At, 1, 1); PG8_STAGE(PG8_SA(1, 0), a3, voffA);
            PG8_BAR; PG8_WAIT_L(0); PG8_MMA(1, 0, At, B0); PG8_BAR; PG8_SCHED;
            PG8_STAGE(PG8_SB(1, 1), b3 + hstep, voffB);
            PG8_WAIT_V(6); PG8_BAR; PG8_MMA(1, 1, At, B1); PG8_BAR;
        }
        PG8_STAMP();
        if constexpr (!Epi::AFTER_DRAIN) { E(acc, cur, wr, wc, fr, fq); S.done(cur); }
        PG8_STAMP();
        if (!has_next) break;
#pragma unroll
        for (int a = 0; a < 2; ++a)
#pragma unroll
            for (int b = 0; b < 2; ++b)
#pragma unroll
                for (int m = 0; m < 4; ++m)
#pragma unroll
                    for (int n = 0; n < 2; ++n) acc[a][b][m][n] = (f32x4){0.f, 0.f, 0.f, 0.f};
        cur = nxt; cA = nA; cB = nB; ++ui;
    }
    PG8_WAIT_V(0);
    if (wr == 0) PG8_BAR;
    PG8_BAR;
    if constexpr (Epi::AFTER_DRAIN) { E.fused(acc, cur, wr, wc, fr, fq, lds, wid, lane); S.done(cur); }
    PG8_STAMP();
    if (STAMP && wid == 0) { stamps[lane] = lane < nts ? (((unsigned long long)(unsigned)ts_hi << 32) | (unsigned)ts_lo) : 0ull;
        if (lane == 62) stamps[62] = rt_entry; if (lane == 63) stamps[63] = (unsigned long long)wall_clock64(); }
#undef PG8_STAMP
#undef PG8_SA
#undef PG8_SB
#undef PG8_STAGE
#undef PG8_LDA
#undef PG8_LDB
#undef PG8_MMA
#undef PG8_WAIT_V
#undef PG8_WAIT_L
#undef PG8_BAR
#undef PG8_SCHED
}
}

DI void head_norm_rope(f32x4 (&acc)[4][4], const float* gain, const float* ropeT, int tok0, bool rope, float outscale) {
  const int lane = otid() & 63, l15 = lane & 15, lg = lane >> 4;
  float gn[4][4];
#pragma unroll
  for (int mt = 0; mt < 4; ++mt) { float4 g4 = *(const float4*)(gain + 16 * mt + 4 * lg); gn[mt][0] = g4.x; gn[mt][1] = g4.y; gn[mt][2] = g4.z; gn[mt][3] = g4.w; }
#pragma unroll
  for (int nt = 0; nt < 4; ++nt) {
    float ss = 0.f;
#pragma unroll
    for (int mt = 0; mt < 4; ++mt)
#pragma unroll
      for (int i = 0; i < 4; ++i) ss += acc[mt][nt][i] * acc[mt][nt][i];
    ss += shx(ss, 16); ss += shx(ss, 32);
    const float rinv = rsqrtf(ss * (1.f / 64.f) + 1e-6f);
#pragma unroll
    for (int mt = 0; mt < 4; ++mt)
#pragma unroll
      for (int i = 0; i < 4; ++i) acc[mt][nt][i] = acc[mt][nt][i] * rinv * gn[mt][i];
    if (rope) {
      const float* rt = ropeT + (size_t)(tok0 + 16 * nt + l15) * 16 + 4 * (lg & 1);
      const float4 c4 = *(const float4*)rt, s4 = *(const float4*)(rt + 8);
      const float cs[4] = {c4.x, c4.y, c4.z, c4.w}, sn[4] = {s4.x, s4.y, s4.z, s4.w};
#pragma unroll
      for (int i = 0; i < 4; ++i) {
        const float own = acc[0][nt][i];
        const float oth = shx(own, 32);
        acc[0][nt][i] = (lg < 2) ? (own * cs[i] - oth * sn[i]) : (oth * sn[i] + own * cs[i]);
      }
    }
#pragma unroll
    for (int mt = 0; mt < 4; ++mt)
#pragma unroll
      for (int i = 0; i < 4; ++i) acc[mt][nt][i] *= outscale;
  }
}

DI void store_rowmajor(const f32x4 (&acc)[4][4], bf16_t* dst, size_t ld) {
  const int lane = otid() & 63, l15 = lane & 15, lg = lane >> 4, odd = lg & 1;
#pragma unroll
  for (int p = 0; p < 2; ++p) {
    bf16_t* rowp = dst + (size_t)(16 * (2 * p + odd) + l15) * ld + 4 * (lg - odd);
#pragma unroll
    for (int mt = 0; mt < 4; ++mt) {
      unsigned ax = pack2(acc[mt][2 * p][0], acc[mt][2 * p][1]), ay = pack2(acc[mt][2 * p][2], acc[mt][2 * p][3]);
      unsigned bx = pack2(acc[mt][2 * p + 1][0], acc[mt][2 * p + 1][1]), by = pack2(acc[mt][2 * p + 1][2], acc[mt][2 * p + 1][3]);
      const auto r0 = __builtin_amdgcn_permlane16_swap(ax, bx, false, false);
      const auto r1 = __builtin_amdgcn_permlane16_swap(ay, by, false, false);
      uint4 v; v.x = r0[0]; v.y = r1[0]; v.z = r0[1]; v.w = r1[1];
      *(uint4*)(rowp + 16 * mt) = v;
    }
  }
}
DI void store_transposed(const f32x4 (&acc)[4][4], bf16_t* dst, size_t ld) {
  const int lane = otid() & 63, l15 = lane & 15, lg = lane >> 4;
#pragma unroll
  for (int nt = 0; nt < 4; ++nt)
#pragma unroll
    for (int mt = 0; mt < 4; ++mt)
#pragma unroll
      for (int i = 0; i < 4; ++i) dst[(size_t)(16 * mt + 4 * lg + i) * ld + 32 * (nt >> 1) + (l15 >> 2) * 8 + (nt & 1) * 4 + (l15 & 3)] = f2bf(acc[mt][nt][i]);
}

DI void inproj_epilogue(const Params& P, f32x4 (&acc)[4][4], const int ft, const int tok0) {
  unsigned char* ws = P.ws;
  const int lane = otid() & 63, l15 = lane & 15, lg = lane >> 4;
  const int b = tok0 >> 13, s0 = tok0 & (SEQ - 1);
  const float* ropeT = (const float*)(ws + OFF_ROPE);
  if (ft < 8) {
    head_norm_rope(acc, P.g_q_nsa, ropeT, tok0, true, 0.18033688011112042f);
    store_rowmajor(acc, (bf16_t*)(ws + OFF_QN) + ((size_t)(b * 8 + ft) * SEQ + s0) * 64, 64);
  } else if (ft < 20) {
    const int idx = (ft - 8) >> 1, gi = (ft - 8) & 1;
    const size_t rm = ((size_t)(b * 2 + gi) * SEQ + s0) * 64;
    const size_t tr = (size_t)(b * 2 + gi) * 64 * SEQ + s0;
    if (idx == 0) store_rowmajor(acc, (bf16_t*)(ws + OFF_KCRAW) + rm, 64);
    else if (idx == 1) store_rowmajor(acc, (bf16_t*)(ws + OFF_VCRAW) + rm, 64);
    else if (idx == 2) { head_norm_rope(acc, P.g_k_slc, ropeT, tok0, true, 1.f); store_rowmajor(acc, (bf16_t*)(ws + OFF_KS) + rm, 64); }
    else if (idx == 3) store_transposed(acc, (bf16_t*)(ws + OFF_VST) + tr, SEQ);
    else if (idx == 4) { head_norm_rope(acc, P.g_k_win, ropeT, tok0, true, 1.f); store_rowmajor(acc, (bf16_t*)(ws + OFF_KW) + rm, 64); }
    else store_transposed(acc, (bf16_t*)(ws + OFF_VWT) + tr, SEQ);
  } else if (ft < 28 || (ft >= 32 && ft < 36) || (ft >= 40 && ft < 44)) {
    const int zoff = (ft < 28) ? (ft - 20) * 64 : (ft < 36 ? 512 + (ft - 32) * 64 : 768 + (ft - 40) * 64);
#pragma unroll
    for (int mt = 0; mt < 4; ++mt)
#pragma unroll
      for (int nt = 0; nt < 4; ++nt)
#pragma unroll
        for (int i = 0; i < 4; ++i) acc[mt][nt][i] = silu_f(acc[mt][nt][i]);
    store_rowmajor(acc, (bf16_t*)(ws + OFF_ZS) + (size_t)tok0 * 1024 + zoff, 1024);
  } else if (ft < 32) {
    store_rowmajor(acc, (bf16_t*)(ws + OFF_VP) + (size_t)tok0 * 256 + (ft - 28) * 64, 256);
  } else if (ft < 40) {
    head_norm_rope(acc, P.g_q_mem, ropeT, tok0, false, 0.18033688011112042f);
    store_rowmajor(acc, (bf16_t*)(ws + OFF_QM) + ((size_t)(b * 4 + (ft - 36)) * SEQ + s0) * 64, 64);
  } else if (ft == 44) {
    float* gt = (float*)(ws + OFF_GATES);
#pragma unroll
    for (int nt = 0; nt < 4; ++nt)
#pragma unroll
      for (int mt = 0; mt < 2; ++mt)
#pragma unroll
        for (int i = 0; i < 4; ++i) {
          const int f = 16 * mt + 4 * lg + i;
          if (f < 24) gt[(size_t)(tok0 + 16 * nt + l15) * 24 + f] = sigmoid_f(acc[mt][nt][i]);
        }
  }
}

DI void memkv_epilogue(const Params& P, f32x4 (&acc)[4][4], const int ft, const int tok0) {
  unsigned char* ws = P.ws;
  const int b = tok0 >> 8, m0 = tok0 & 255;
  if (ft < 4) {
    head_norm_rope(acc, P.g_k_mem, nullptr, 0, false, 1.f);
    store_rowmajor(acc, (bf16_t*)(ws + OFF_MK) + ((size_t)(b * 4 + ft) * MEML + m0) * 64, 64);
  } else {
    store_transposed(acc, (bf16_t*)(ws + OFF_MVT) + (size_t)(b * 4 + (ft - 4)) * 64 * MEML + m0, MEML);
  }
}

DI void p2_compress_item(const Params& P, int item) {
  unsigned char* ws = P.ws;
  const int which = item >> 6, bg = (item >> 2) & 15, ntile = item & 3;
  const int tid = otid(), lane = tid & 63, w = tid >> 6, l15 = lane & 15, lg = lane >> 4;
  const int n = ntile * 128 + w * 16 + l15;
  const int nc = n < 511 ? n : 510;
  const bf16_t* raw = (const bf16_t*)(ws + (which ? OFF_VCRAW : OFF_KCRAW)) + ((size_t)bg * SEQ + 16 * nc) * 64 + 8 * lg;
  const bf16_t* w1 = (const bf16_t*)(ws + (which ? OFF_WC1V : OFF_WC1K)) + (size_t)l15 * 2048 + 8 * lg;
  f32x4 acc[4];
#pragma unroll
  for (int i = 0; i < 4; ++i) acc[i] = (f32x4){0.f, 0.f, 0.f, 0.f};
#pragma unroll 4
  for (int ks = 0; ks < 64; ++ks) {
    const bf16x8 bq = ld16(raw + ks * 32);
#pragma unroll
    for (int mt = 0; mt < 4; ++mt) acc[mt] = mfma16(ld16(w1 + (size_t)mt * 16 * 2048 + ks * 32), bq, acc[mt]);
  }
  const float* bias = (const float*)(ws + OFF_BIASC) + which * 64;
#pragma unroll
  for (int mt = 0; mt < 4; ++mt)
#pragma unroll
    for (int i = 0; i < 4; ++i) acc[mt][i] = gelu_tanh(acc[mt][i] + bias[16 * mt + 4 * lg + i]);
  const bf16_t* w2 = (const bf16_t*)(ws + (which ? OFF_WC2V : OFF_WC2K)) + (size_t)l15 * 64 + 4 * lg;
  f32x4 a2[4];
#pragma unroll
  for (int i = 0; i < 4; ++i) a2[i] = (f32x4){0.f, 0.f, 0.f, 0.f};
#pragma unroll
  for (int ks2 = 0; ks2 < 2; ++ks2) {
    const bf16x8 hb = pack8(acc[2 * ks2], acc[2 * ks2 + 1]);
#pragma unroll
    for (int ft = 0; ft < 4; ++ft) {
      const bf16_t* wp = w2 + (size_t)ft * 16 * 64 + 32 * ks2;
      a2[ft] = mfma16(ld8x2(wp, wp + 16), hb, a2[ft]);
    }
  }
  const int b = bg >> 1;
  if (which == 0) {
    float ss = 0.f;
#pragma unroll
    for (int ft = 0; ft < 4; ++ft)
#pragma unroll
      for (int i = 0; i < 4; ++i) ss += a2[ft][i] * a2[ft][i];
    ss += shx(ss, 16); ss += shx(ss, 32);
    const float rinv = rsqrtf(ss * (1.f / 64.f) + 1e-6f);
#pragma unroll
    for (int ft = 0; ft < 4; ++ft) {
      const float4 g4 = *(const float4*)(P.g_k_cmp + 16 * ft + 4 * lg);
      a2[ft][0] *= rinv * g4.x; a2[ft][1] *= rinv * g4.y; a2[ft][2] *= rinv * g4.z; a2[ft][3] *= rinv * g4.w;
    }
    const float* rt = (const float*)(ws + OFF_ROPE) + ((size_t)b * SEQ + 16 * nc + 31) * 16 + 4 * (lg & 1);
    const float4 c4 = *(const float4*)rt, s4 = *(const float4*)(rt + 8);
    const float cs[4] = {c4.x, c4.y, c4.z, c4.w}, sn[4] = {s4.x, s4.y, s4.z, s4.w};
#pragma unroll
    for (int i = 0; i < 4; ++i) {
      const float own = a2[0][i];
      const float oth = shx(own, 32);
      a2[0][i] = (lg < 2) ? (own * cs[i] - oth * sn[i]) : (oth * sn[i] + own * cs[i]);
    }
    bf16_t* dst = (bf16_t*)(ws + OFF_KC) + ((size_t)bg * NCP + n) * 64 + 4 * lg;
    const float z = (n < 511) ? 1.f : 0.f;
#pragma unroll
    for (int ft = 0; ft < 4; ++ft) st4bf(dst + 16 * ft, a2[ft][0] * z, a2[ft][1] * z, a2[ft][2] * z, a2[ft][3] * z);
  } else {
    bf16_t* dst = (bf16_t*)(ws + OFF_VCT) + (size_t)bg * 64 * NCP + (n & ~31) + (((n & 15) >> 2) * 8 + ((n >> 4) & 1) * 4 + (n & 3));
    const float z = (n < 511) ? 1.f : 0.f;
#pragma unroll
    for (int ft = 0; ft < 4; ++ft)
#pragma unroll
      for (int i = 0; i < 4; ++i) dst[(size_t)(16 * ft + 4 * lg + i) * NCP] = f2bf(a2[ft][i] * z);
  }
}

enum { M_WIN = 0, M_SEL = 1, M_MEM = 2, M_CMPA = 3, M_CMPB = 4 };
constexpr int SM_IMP = 49152;
constexpr int SM_OACC = SM_IMP;
constexpr int SM_SEL = SM_OACC + 256 * 68 * 4;
constexpr int SM_MASK = SM_SEL + 1024;
constexpr int SM_LIST = SM_MASK + 1024;
constexpr int SM_LACC = SM_LIST + 8192;
constexpr int SM_QS = SM_LACC + 1024;
constexpr int SM_TOTAL = SM_QS + 32768;

template <int MODE>
DI void attn_run(const bf16_t* __restrict__ kbase, const bf16_t* __restrict__ vbase, const int vstride,
                 const int tile_begin, const int tile_end,
                 const bf16x8 (&qf)[2][2], const int (&tq)[2], const int (&tokl)[2],
                 f32x4 (&o)[2][4], float (&m)[2], float (&l)[2], unsigned char* smem, const int tmin, const float negM,
                 uint4& rk0, uint4& rv0, const bool pre  ,
                 const bf16_t* __restrict__ nk, const bf16_t* __restrict__ nv, const int nvs, const int nt  ,
                 const int ovr = -1  ) {
  if (tile_begin >= tile_end) return;
  const int tid = otid(), lane = tid & 63, l15 = lane & 15, lg = lane >> 4;
  const int srow = tid >> 3, sc = tid & 7;
  const unsigned short* selbits = (const unsigned short*)(smem + SM_SEL);
  float* imp = (float*)(smem + SM_IMP);
#define GL_(rk, rv, t) { rk = *(const uint4*)(kbase + ((size_t)((t) * 64 + srow)) * 64 + sc * 8); \
      if (MODE != M_CMPA) rv = *(const uint4*)(vbase + (size_t)srow * vstride + (t) * 64 + sc * 8); }
#define SW_(rk, rv, buf) { unsigned char* d_ = smem + (buf) * 9216 + srow * 128 + ((sc ^ (srow & 7)) << 4); *(uint4*)(d_) = rk; \
      if (MODE != M_CMPA) *(uint4*)(d_ + 18432) = rv; }
  f32x4 lacc[2] = {(f32x4){0.f, 0.f, 0.f, 0.f}, (f32x4){0.f, 0.f, 0.f, 0.f}};
  const bf16x8 ones = {(short)0x3F80, (short)0x3F80, (short)0x3F80, (short)0x3F80, (short)0x3F80, (short)0x3F80, (short)0x3F80, (short)0x3F80};
  auto compute = [&](const int t, const int buf) __attribute__((always_inline)) {
    const int xsw = ((lg ^ (l15 & 7)) << 4);
    const unsigned char* ck = smem + buf * 9216 + l15 * 128;
    const unsigned char* cv = smem + 18432 + buf * 9216 + l15 * 128;
    bool bit[2] = {true, true};
    bool need = true;
    if (MODE == M_SEL) {
#pragma unroll
      for (int c = 0; c < 2; ++c) bit[c] = (selbits[tokl[c] * 8 + (t >> 4)] >> (t & 15)) & 1;
      need = __any(bit[0] || bit[1]) != 0;
    }
    if (need) {
      f32x4 s[2][4];
#pragma unroll
      for (int c = 0; c < 2; ++c) {
        float ci = negM;
        if (MODE == M_SEL) ci = bit[c] ? negM : -__builtin_inff();
        const f32x4 cinit = {ci, ci, ci, ci};
#pragma unroll
        for (int kt = 0; kt < 4; ++kt) s[c][kt] = cinit;
      }
      {
        bf16x8 kf[2][4];
#pragma unroll
        for (int ks = 0; ks < 2; ++ks)
#pragma unroll
          for (int kt = 0; kt < 4; ++kt) kf[ks][kt] = ld16(ck + kt * 16 * 128 + (xsw ^ (ks << 6)));
        __builtin_amdgcn_sched_barrier(0);
#pragma unroll
        for (int ks = 0; ks < 2; ++ks)
#pragma unroll
          for (int kt = 0; kt < 4; ++kt) {
            s[0][kt] = mfma16(kf[ks][kt], qf[0][ks], s[0][kt]);
            s[1][kt] = mfma16(kf[ks][kt], qf[1][ks], s[1][kt]);
          }
      }
      bf16x8 vf[2][4];
      if (MODE != M_CMPA) {
#pragma unroll
        for (int ks2 = 0; ks2 < 2; ++ks2)
#pragma unroll
          for (int dt = 0; dt < 4; ++dt) vf[ks2][dt] = ld16(cv + dt * 16 * 128 + (xsw ^ (ks2 << 6)));
      }
      __builtin_amdgcn_sched_barrier(0);
      bool needmask = false;
      if (MODE == M_WIN) needmask = (t * 64 + 63 > tmin) || (t * 64 <= tmin + 7 - 512);
      if (MODE == M_SEL) needmask = (t * 64 + 63 > tmin);
      if (MODE == M_CMPA || MODE == M_CMPB) needmask = (16 * (t * 64 + 63) + 31 > tmin);
      if (needmask) {
        const int key0 = t * 64 + 4 * lg;
#pragma unroll
        for (int c = 0; c < 2; ++c)
#pragma unroll
          for (int kt = 0; kt < 4; ++kt)
#pragma unroll
            for (int i = 0; i < 4; ++i) {
              const int kk = key0 + 16 * kt + i;
              bool ok = true;
              if (MODE == M_WIN) ok = (kk <= tq[c]) && (kk > tq[c] - 512);
              if (MODE == M_SEL) ok = (kk <= tq[c]);
              if (MODE == M_CMPA || MODE == M_CMPB) ok = (16 * kk + 31 <= tq[c]);
              s[c][kt][i] = ok ? s[c][kt][i] : -__builtin_inff();
            }
      }
      bf16x8 pf[2][2];
#pragma unroll
      for (int c = 0; c < 2; ++c) {
#pragma unroll
        for (int kt = 0; kt < 4; ++kt) {
          float p0 = ex2(s[c][kt][0]), p1 = ex2(s[c][kt][1]), p2 = ex2(s[c][kt][2]), p3 = ex2(s[c][kt][3]);
          if (MODE == M_CMPB) { p0 *= l[c]; p1 *= l[c]; p2 *= l[c]; p3 *= l[c]; }
          s[c][kt][0] = p0; s[c][kt][1] = p1; s[c][kt][2] = p2; s[c][kt][3] = p3;
        }
        if (MODE == M_CMPB) {
          const int key0 = t * 64 + 4 * lg;
#pragma unroll
          for (int kt = 0; kt < 4; ++kt) {
            float pa = s[c][kt][0] + s[c][kt][1] + s[c][kt][2] + 0.5f * s[c][kt][3];
            float pb = 0.5f * s[c][kt][3];
            pa += dpp_x1f(pa); pa += dpp_x2f(pa);
            pb += dpp_x1f(pb); pb += dpp_x2f(pb);
            if ((lane & 3) == 0) {
              const int j = (key0 + 16 * kt) >> 2;
              float* ip = imp + tokl[c] * 129 + j;
              ip[0] += pa;
              __builtin_amdgcn_fence(__ATOMIC_RELEASE, "wavefront");
              if (j + 1 < 128) ip[1] += pb;
              __builtin_amdgcn_fence(__ATOMIC_RELEASE, "wavefront");
            }
          }
        }
        pf[c][0] = pack8(s[c][0], s[c][1]);
        pf[c][1] = pack8(s[c][2], s[c][3]);
        if (MODE != M_CMPB) {
          lacc[c] = mfma16(ones, pf[c][0], lacc[c]);
          lacc[c] = mfma16(ones, pf[c][1], lacc[c]);
        }
      }
      if (MODE != M_CMPA) {
#pragma unroll
        for (int ks2 = 0; ks2 < 2; ++ks2)
#pragma unroll
          for (int dt = 0; dt < 4; ++dt) {
            o[0][dt] = mfma16(vf[ks2][dt], pf[0][ks2], o[0][dt]);
            o[1][dt] = mfma16(vf[ks2][dt], pf[1][ks2], o[1][dt]);
          }
      }
    }
  };
  if (!pre) GL_(rk0, rv0, (ovr >= 0 ? ovr : tile_begin));
  SW_(rk0, rv0, 0);
  __syncthreads();
#pragma unroll 1
  for (int t = tile_begin; t < tile_end; ++t) {
    const int buf = (t - tile_begin) & 1;
    const bool more = (t + 1 < tile_end);
    if (more) GL_(rk0, rv0, t + 1)
    else if (nt >= 0) {
      rk0 = *(const uint4*)(nk + ((size_t)(nt * 64 + srow)) * 64 + sc * 8);
      rv0 = *(const uint4*)(nv + (size_t)srow * nvs + nt * 64 + sc * 8);
    }
    compute((t == tile_begin && ovr >= 0) ? ovr : t, buf);
    if (more) SW_(rk0, rv0, buf ^ 1);
    __syncthreads();
  }
#undef GL_
#undef SW_
  if (MODE != M_CMPB) { l[0] += lacc[0][0]; l[1] += lacc[1][0]; }
}

DI void attn_reset(f32x4 (&o)[2][4], float (&m)[2], float (&l)[2]) {
#pragma unroll
  for (int c = 0; c < 2; ++c) {
    m[c] = -__builtin_inff(); l[c] = 0.f;
#pragma unroll
    for (int dt = 0; dt < 4; ++dt) o[c][dt] = (f32x4){0.f, 0.f, 0.f, 0.f};
  }
}
DI void attn_accum(f32x4 (&ot)[2][4], const f32x4 (&o)[2][4], const float (&l)[2], const float (&gate)[2]) {
#pragma unroll
  for (int c = 0; c < 2; ++c) {
    const float f = gate[c] / fmaxf(l[c], 1.17549435e-38f);
#pragma unroll
    for (int dt = 0; dt < 4; ++dt) ot[c][dt] += o[c][dt] * f;
  }
}

DI void topk_select(unsigned char* smem, int cur) {
  const int tid = otid(), lane = tid & 63, tok = tid >> 3, sub = tid & 7;
  const float* imp = (const float*)(smem + SM_IMP);
  unsigned short* selbits = (unsigned short*)(smem + SM_SEL);
  unsigned bits = 0;
  if (cur <= 15) {
#pragma unroll
    for (int q = 0; q < 16; ++q) if (16 * sub + q <= cur) bits |= 1u << q;
  } else {
    unsigned key[16];
#pragma unroll
    for (int q = 0; q < 16; ++q) {
      const int j = 16 * sub + q;
      const bool cand = (j >= 1) && (j <= cur - 2);
      key[q] = cand ? (__float_as_uint(imp[tok * 129 + j]) + 1u) : 0u;
    }
    unsigned T = 0;
    bool done = false;
#pragma unroll 1
    for (int b = 30; b >= 0; --b) {
      const unsigned cnd = T | (1u << b);
      int cnt = 0;
#pragma unroll
      for (int q = 0; q < 16; ++q) cnt += (key[q] >= cnd) ? 1 : 0;
      cnt += dpp_x1(cnt); cnt += dpp_x2(cnt); cnt += dpp_hm(cnt);
      if (!done && cnt >= 13) T = cnd;
      done = done || (cnt == 13);
      if (__all(done)) break;
    }
    int cgt = 0, ceq = 0;
#pragma unroll
    for (int q = 0; q < 16; ++q) { cgt += (key[q] > T) ? 1 : 0; ceq += (key[q] == T) ? 1 : 0; }
    int gt_tot = cgt;
    gt_tot += dpp_x1(gt_tot); gt_tot += dpp_x2(gt_tot); gt_tot += dpp_hm(gt_tot);
    int pre = 0;
#pragma unroll
    for (int k = 0; k < 8; ++k) { const int v = __shfl(ceq, (lane & ~7) | k, 64); if (k < sub) pre += v; }
    const int quota = 13 - gt_tot;
#pragma unroll
    for (int q = 0; q < 16; ++q) {
      if (key[q] > T) bits |= 1u << q;
      else if (key[q] == T && T != 0u) { if (pre < quota) bits |= 1u << q; ++pre; }
    }
    if (sub == 0) bits |= 1u;
    if ((cur >> 4) == sub) bits |= 1u << (cur & 15);
    if (((cur - 1) >> 4) == sub) bits |= 1u << ((cur - 1) & 15);
  }
  selbits[tok * 8 + sub] = (unsigned short)bits;
}


DI void sel_sparse(const bf16_t* __restrict__ kbase, const bf16_t* __restrict__ vbase, const int jend  ,
                   unsigned char* smem, const float negM) {
  const int tid = otid(), lane = tid & 63, w = __builtin_amdgcn_readfirstlane(tid >> 6), l15 = lane & 15, lg = lane >> 4;
  const int srow = tid >> 3, sc = tid & 7;
  const unsigned* mask = (const unsigned*)(smem + SM_MASK);
  const unsigned char* list = smem + SM_LIST;
  float* oacc = (float*)(smem + SM_OACC);
  float* lacc_s = (float*)(smem + SM_LACC);
  const unsigned char* qs = smem + SM_QS;
  const bf16x8 ones = {(short)0x3F80, (short)0x3F80, (short)0x3F80, (short)0x3F80, (short)0x3F80, (short)0x3F80, (short)0x3F80, (short)0x3F80};
  uint4 rkA, rvA, rkB, rvB, rkC, rvC;
#define GLS_(rk, rv, t) { const int t_ = ((t) < jend) ? (t) : (jend - 1); rk = *(const uint4*)(kbase + ((size_t)(t_ * 64 + srow)) * 64 + sc * 8); rv = *(const uint4*)(vbase + (size_t)srow * SEQ + t_ * 64 + sc * 8); }
#define SWS_(rk, rv, u) { unsigned char* d_ = smem + (u) * 8192 + srow * 128 + ((sc ^ (srow & 7)) << 4); *(uint4*)(d_) = rk; *(uint4*)(d_ + 24576) = rv; }
  GLS_(rkA, rvA, 1); GLS_(rkB, rvB, 2); GLS_(rkC, rvC, 3);
  SWS_(rkA, rvA, 0); SWS_(rkB, rvB, 1); SWS_(rkC, rvC, 2);
  GLS_(rkA, rvA, 4); GLS_(rkB, rvB, 5); GLS_(rkC, rvC, 6);
  __syncthreads();
#pragma unroll 1
  for (int jb = 1; jb < jend; jb += 3) {
    const int n0 = __builtin_popcount(mask[2 * jb]) + __builtin_popcount(mask[2 * jb + 1]);
    const int n1 = (jb + 1 < jend) ? __builtin_popcount(mask[2 * jb + 2]) + __builtin_popcount(mask[2 * jb + 3]) : 0;
    const int n2 = (jb + 2 < jend) ? __builtin_popcount(mask[2 * jb + 4]) + __builtin_popcount(mask[2 * jb + 5]) : 0;
    const int c0 = (n0 + 3) >> 2, c1 = (n1 + 3) >> 2, c2 = (n2 + 3) >> 2;
    const int T = __builtin_amdgcn_readfirstlane(c0 + c1 + c2);
#pragma unroll 1
    for (int q0 = 0; q0 < T; q0 += 8) {
      const int q = q0 + w;
      const bool act = q < T;
      int u = 0, ct = q;
      if (ct >= c0) { ct -= c0; u = 1; if (ct >= c1) { ct -= c1; u = 2; } }
      f32x4 oo[4];
      float la0 = 0.f;
      int row = 0;
      bool valid = false;
#pragma unroll
      for (int dt = 0; dt < 4; ++dt) oo[dt] = (f32x4){0.f, 0.f, 0.f, 0.f};
      if (act) {
        const int j = jb + u;
        const int n = (u == 0) ? n0 : (u == 1) ? n1 : n2;
        const int xsw = ((lg ^ (l15 & 7)) << 4);
        const unsigned char* ck = smem + u * 8192 + l15 * 128;
        const unsigned char* cv = smem + 24576 + u * 8192 + l15 * 128;
        bf16x8 kf[2][4], vf[2][4];
#pragma unroll
        for (int ks = 0; ks < 2; ++ks)
#pragma unroll
          for (int kt = 0; kt < 4; ++kt) { kf[ks][kt] = ld16(ck + kt * 16 * 128 + (xsw ^ (ks << 6))); vf[ks][kt] = ld16(cv + kt * 16 * 128 + (xsw ^ (ks << 6))); }
        const int idx = 4 * ct + (l15 >> 2);
        valid = idx < n;
        const int tok = valid ? (int)list[j * 64 + idx] : 0;
        row = tok * 4 + (l15 & 3);
        const unsigned char* qr = qs + row * 128;
        const bf16x8 qa = ld16(qr + ((lg ^ (row & 7)) << 4)), qb = ld16(qr + (((4 + lg) ^ (row & 7)) << 4));
        const float ci = valid ? negM : -__builtin_inff();
        f32x4 sv[4];
#pragma unroll
        for (int kt = 0; kt < 4; ++kt) sv[kt] = (f32x4){ci, ci, ci, ci};
#pragma unroll
        for (int kt = 0; kt < 4; ++kt) { sv[kt] = mfma16(kf[0][kt], qa, sv[kt]); sv[kt] = mfma16(kf[1][kt], qb, sv[kt]); }
#pragma unroll
        for (int kt = 0; kt < 4; ++kt)
#pragma unroll
          for (int i = 0; i < 4; ++i) sv[kt][i] = ex2(sv[kt][i]);
        const bf16x8 pa = pack8(sv[0], sv[1]), pb = pack8(sv[2], sv[3]);
        f32x4 la = (f32x4){0.f, 0.f, 0.f, 0.f};
#pragma unroll
        for (int dt = 0; dt < 4; ++dt) { oo[dt] = mfma16(vf[0][dt], pa, oo[dt]); oo[dt] = mfma16(vf[1][dt], pb, oo[dt]); }
        la = mfma16(ones, pa, la); la = mfma16(ones, pb, la);
        la0 = la[0];
      }
      const bool lastr = (q0 + 8 >= T);
#pragma unroll
      for (int uu = 0; uu < 3; ++uu) {
        if (uu) __syncthreads();
        if (uu == 1 && lastr && jb + 3 < jend) {
          SWS_(rkA, rvA, 0); SWS_(rkB, rvB, 1); SWS_(rkC, rvC, 2);
          GLS_(rkA, rvA, jb + 6); GLS_(rkB, rvB, jb + 7); GLS_(rkC, rvC, jb + 8);
        }
        if (act && valid && u == uu) {
          float* op = oacc + row * 68 + 4 * lg;
          f32x4 cur4[4];
#pragma unroll
          for (int dt = 0; dt < 4; ++dt) cur4[dt] = *(const f32x4*)(op + 16 * dt);
#pragma unroll
          for (int dt = 0; dt < 4; ++dt) *(f32x4*)(op + 16 * dt) = cur4[dt] + oo[dt];
          if (lg == 0) lacc_s[row] += la0;
        }
      }
      if (!lastr) __syncthreads();
    }
    if (T == 0 && jb + 3 < jend) {
      SWS_(rkA, rvA, 0); SWS_(rkB, rvB, 1); SWS_(rkC, rvC, 2);
      GLS_(rkA, rvA, jb + 6); GLS_(rkB, rvB, jb + 7); GLS_(rkC, rvC, jb + 8);
    }
    __syncthreads();
  }
#undef GLS_
#undef SWS_
}

DI void p3_nsa_item(const Params& P, const int bg, const int qt, unsigned char* smem) {
  unsigned char* ws = P.ws;
  const int b = bg >> 1, gi = bg & 1, t0 = qt * 64, cur = qt;
  const int tid = otid(), lane = tid & 63, w = tid >> 6, l15 = lane & 15, lg = lane >> 4;
  int tokl[2], tq[2];
  bf16x8 qf[2][2];
  float gt[3][2];
  const int tmin = __builtin_amdgcn_readfirstlane(t0 + 8 * w);
  const float* shifts = (const float*)(ws + OFF_CNT + 128);
  const int head = 4 * gi + (l15 & 3);
#pragma unroll
  for (int c = 0; c < 2; ++c) {
    tokl[c] = 8 * w + 4 * c + (l15 >> 2);
    tq[c] = t0 + tokl[c];
    const bf16_t* qp = (const bf16_t*)(ws + OFF_QN) + ((size_t)(b * 8 + head) * SEQ + tq[c]) * 64 + 8 * lg;
    qf[c][0] = ld16(qp); qf[c][1] = ld16(qp + 32);
    const float* gp = (const float*)(ws + OFF_GATES) + (size_t)(b * SEQ + tq[c]) * 24 + head * 3;
    gt[0][c] = gp[0]; gt[1][c] = gp[1]; gt[2][c] = gp[2];
  }
  f32x4 ot[2][4], o[2][4];
  float m[2], l[2];
#pragma unroll
  for (int c = 0; c < 2; ++c)
#pragma unroll
    for (int dt = 0; dt < 4; ++dt) ot[c][dt] = (f32x4){0.f, 0.f, 0.f, 0.f};
  float* imp = (float*)(smem + SM_IMP);
  for (int i = tid; i < 64 * 129; i += 512) imp[i] = 0.f;
  const bf16_t* kc = (const bf16_t*)(ws + OFF_KC) + (size_t)bg * NCP * 64;
  const bf16_t* vct = (const bf16_t*)(ws + OFF_VCT) + (size_t)bg * 64 * NCP;
  const int ctiles = (qt >> 4) + 1;
#if EN_CMP
  attn_reset(o, m, l);
  uint4 pk_ = make_uint4(0, 0, 0, 0), pv_ = make_uint4(0, 0, 0, 0);
  attn_run<M_CMPA>(kc, vct, NCP, 0, ctiles, qf, tq, tokl, o, m, l, smem, tmin, shifts[2], pk_, pv_, false, kc, vct, NCP, 0);
#pragma unroll
  for (int c = 0; c < 2; ++c) l[c] = 1.f / fmaxf(l[c], 1.17549435e-38f);
  {
    const bf16_t* ksb_ = (const bf16_t*)(ws + OFF_KS) + (size_t)bg * SEQ * 64;
    const bf16_t* vsb_ = (const bf16_t*)(ws + OFF_VST) + (size_t)bg * 64 * SEQ;
    attn_run<M_CMPB>(kc, vct, NCP, 0, ctiles, qf, tq, tokl, o, m, l, smem, tmin, shifts[2], pk_, pv_, true, ksb_, vsb_, SEQ, (cur <= 29) ? 0 : -1);
  }
#pragma unroll
  for (int c = 0; c < 2; ++c)
#pragma unroll
    for (int dt = 0; dt < 4; ++dt) ot[c][dt] += o[c][dt] * gt[0][c];
#else
  __syncthreads();
#endif
  topk_select(smem, cur);
  __syncthreads();
#if EN_SEL
  {
    const bf16_t* kwb = (const bf16_t*)(ws + OFF_KW) + (size_t)bg * SEQ * 64;
    const bf16_t* vwb = (const bf16_t*)(ws + OFF_VWT) + (size_t)bg * 64 * SEQ;
    const int wt0 = (qt >= 8) ? (qt - 8) : 0;
    const bf16_t* ksb = (const bf16_t*)(ws + OFF_KS) + (size_t)bg * SEQ * 64;
    const bf16_t* vsb = (const bf16_t*)(ws + OFF_VST) + (size_t)bg * 64 * SEQ;
    if (cur <= 29) {
      attn_reset(o, m, l);
      attn_run<M_SEL>(ksb, vsb, SEQ, 0, cur + 1, qf, tq, tokl, o, m, l, smem, tmin, shifts[0], pk_, pv_, true, kwb, vwb, SEQ, wt0);
    } else {
      float* oacc = (float*)(smem + SM_OACC);
      for (int i = tid; i < 256 * 68; i += 512) oacc[i] = 0.f;
      if (tid < 256) { ((float*)(smem + SM_LACC))[tid] = 0.f; ((unsigned*)(smem + SM_MASK))[tid] = 0u; }
#pragma unroll
      for (int c = 0; c < 2; ++c) {
        const int row = tokl[c] * 4 + (l15 & 3);
        unsigned char* qr = smem + SM_QS + row * 128;
        *(bf16x8*)(qr + ((lg ^ (row & 7)) << 4)) = qf[c][0];
        *(bf16x8*)(qr + (((4 + lg) ^ (row & 7)) << 4)) = qf[c][1];
      }
      __syncthreads();
      {
        const int tok = tid >> 3, sub = tid & 7;
        unsigned bits = ((const unsigned short*)(smem + SM_SEL))[tok * 8 + sub];
        unsigned* mk = (unsigned*)(smem + SM_MASK);
        while (bits) {
          const int q = __builtin_ctz(bits); bits &= bits - 1;
          const int j = 16 * sub + q;
          if (j != 0 && j < cur - 1) atomicOr(&mk[2 * j + (tok >> 5)], 1u << (tok & 31));
        }
      }
      __syncthreads();
      if (tid >= 1 && tid < cur - 1) {
        const unsigned* mk = (const unsigned*)(smem + SM_MASK);
        unsigned char* ls = smem + SM_LIST + tid * 64;
        unsigned m0 = mk[2 * tid], m1 = mk[2 * tid + 1];
        int k = 0;
        while (m0) { ls[k++] = (unsigned char)__builtin_ctz(m0); m0 &= m0 - 1; }
        while (m1) { ls[k++] = (unsigned char)(32 + __builtin_ctz(m1)); m1 &= m1 - 1; }
      }
      __syncthreads();
      sel_sparse(ksb, vsb, cur - 1, smem, shifts[0]);
      attn_reset(o, m, l);
      attn_run<M_SEL>(ksb, vsb, SEQ, cur - 2, cur + 1, qf, tq, tokl, o, m, l, smem, tmin, shifts[0], pk_, pv_, false, kwb, vwb, SEQ, wt0, 0);
#pragma unroll
      for (int c = 0; c < 2; ++c) {
        const int row = tokl[c] * 4 + (l15 & 3);
        const float* op = (const float*)(smem + SM_OACC) + row * 68 + 4 * lg;
#pragma unroll
        for (int dt = 0; dt < 4; ++dt)
#pragma unroll
          for (int i = 0; i < 4; ++i) o[c][dt][i] += op[16 * dt + i];
        l[c] += ((const float*)(smem + SM_LACC))[row];
      }
    }
  }
  attn_accum(ot, o, l, gt[1]);
#endif
#if EN_WIN
  attn_reset(o, m, l);
  attn_run<M_WIN>((const bf16_t*)(ws + OFF_KW) + (size_t)bg * SEQ * 64, (const bf16_t*)(ws + OFF_VWT) + (size_t)bg * 64 * SEQ, SEQ,
                  (qt >= 8) ? (qt - 8) : 0, cur + 1, qf, tq, tokl, o, m, l, smem, tmin, shifts[1], pk_, pv_, (EN_SEL != 0), nullptr, nullptr, 0, -1);
  attn_accum(ot, o, l, gt[2]);
#endif
#pragma unroll
  for (int c = 0; c < 2; ++c) {
    const size_t off = (size_t)(b * SEQ + tq[c]) * 1024 + head * 64 + 4 * lg;
    const bf16_t* zp = (const bf16_t*)(ws + OFF_ZS) + off;
    bf16_t* yp = (bf16_t*)(ws + OFF_Y) + off;
#pragma unroll
    for (int dt = 0; dt < 4; ++dt) {
      const uint2 zz = *(const uint2*)(zp + 16 * dt);
      st4bf(yp + 16 * dt, ot[c][dt][0] * bf2f((bf16_t)(zz.x & 0xffff)), ot[c][dt][1] * bf2f((bf16_t)(zz.x >> 16)),
            ot[c][dt][2] * bf2f((bf16_t)(zz.y & 0xffff)), ot[c][dt][3] * bf2f((bf16_t)(zz.y >> 16)));
    }
  }
}

DI void p3_mem_item(const Params& P, const int bh, const int qt, unsigned char* smem) {
  unsigned char* ws = P.ws;
  const int b = bh >> 2, h = bh & 3, t0 = qt * 256;
  const int tid = otid(), lane = tid & 63, w = tid >> 6, l15 = lane & 15, lg = lane >> 4;
  int tokl[2], tq[2];
  bf16x8 qf[2][2];
  const int tmin = 0;
#pragma unroll
  for (int c = 0; c < 2; ++c) {
    tokl[c] = 0;
    tq[c] = t0 + 32 * w + 16 * c + l15;
    const bf16_t* qp = (const bf16_t*)(ws + OFF_QM) + ((size_t)bh * SEQ + tq[c]) * 64 + 8 * lg;
    qf[c][0] = ld16(qp); qf[c][1] = ld16(qp + 32);
  }
  f32x4 o[2][4];
  float m[2], l[2];
  uint4 pk_ = make_uint4(0, 0, 0, 0), pv_ = make_uint4(0, 0, 0, 0);
  attn_reset(o, m, l);
  attn_run<M_MEM>((const bf16_t*)(ws + OFF_MK) + (size_t)bh * MEML * 64, (const bf16_t*)(ws + OFF_MVT) + (size_t)bh * 64 * MEML, MEML,
                  0, 4, qf, tq, tokl, o, m, l, smem, tmin, ((const float*)(ws + OFF_CNT + 128))[3], pk_, pv_, false, nullptr, nullptr, 0, -1);
#pragma unroll
  for (int c = 0; c < 2; ++c) {
    const float f = 1.f / fmaxf(l[c], 1.17549435e-38f);
    const size_t off = (size_t)(b * SEQ + tq[c]) * 1024 + 768 + h * 64 + 4 * lg;
    const bf16_t* zp = (const bf16_t*)(ws + OFF_ZS) + off;
    bf16_t* yp = (bf16_t*)(ws + OFF_Y) + off;
#pragma unroll
    for (int dt = 0; dt < 4; ++dt) {
      const uint2 zz = *(const uint2*)(zp + 16 * dt);
      st4bf(yp + 16 * dt, o[c][dt][0] * f * bf2f((bf16_t)(zz.x & 0xffff)), o[c][dt][1] * f * bf2f((bf16_t)(zz.x >> 16)),
            o[c][dt][2] * f * bf2f((bf16_t)(zz.y & 0xffff)), o[c][dt][3] * f * bf2f((bf16_t)(zz.y >> 16)));
    }
  }
}

DI void p3_pool_item(const Params& P, int item, unsigned char* smem) {
  unsigned char* ws = P.ws;
  const int tok0 = item * 128, s0 = tok0 & (SEQ - 1);
  const int tid = otid(), lane = tid & 63, w = tid >> 6, l15 = lane & 15, lg = lane >> 4;
  const bf16_t* vp = (const bf16_t*)(ws + OFF_VP);
  for (int q = tid; q < 143 * 32; q += 512) {
    const int r = q >> 5, cch = q & 31;
    const int s = s0 - 15 + r;
    uint4 v = make_uint4(0, 0, 0, 0);
    if (s >= 0) v = *(const uint4*)(vp + (size_t)(tok0 - 15 + r) * 256 + cch * 8);
    *(uint4*)(smem + r * 528 + cch * 16) = v;
  }
  __syncthreads();
  const int rown = 15 + 16 * w + l15;
  const int s = s0 + 16 * w + l15;
  const int tok = tok0 + 16 * w + l15;
#pragma unroll
  for (int gp = 0; gp < 4; ++gp) {
    const int win = 2 << gp;
    const float rc = 1.f / (float)((s + 1 < win) ? (s + 1) : win);
    f32x4 acc[4];
#pragma unroll
    for (int i = 0; i < 4; ++i) acc[i] = (f32x4){0.f, 0.f, 0.f, 0.f};
#pragma unroll
    for (int ks = 0; ks < 2; ++ks) {
      const int cb = (gp * 64 + 32 * ks + 8 * lg) * 2;
      float sum[8];
#pragma unroll
      for (int j = 0; j < 8; ++j) sum[j] = 0.f;
      uint4 own = make_uint4(0, 0, 0, 0);
      for (int i = 0; i < win; ++i) {
        const uint4 v = *(const uint4*)(smem + (rown - i) * 528 + cb);
        if (i == 0) own = v;
        sum[0] += bf2f((bf16_t)(v.x & 0xffff)); sum[1] += bf2f((bf16_t)(v.x >> 16));
        sum[2] += bf2f((bf16_t)(v.y & 0xffff)); sum[3] += bf2f((bf16_t)(v.y >> 16));
        sum[4] += bf2f((bf16_t)(v.z & 0xffff)); sum[5] += bf2f((bf16_t)(v.z >> 16));
        sum[6] += bf2f((bf16_t)(v.w & 0xffff)); sum[7] += bf2f((bf16_t)(v.w >> 16));
      }
      uint4 pk;
      pk.x = pack2(sum[0] * rc - bf2f((bf16_t)(own.x & 0xffff)), sum[1] * rc - bf2f((bf16_t)(own.x >> 16)));
      pk.y = pack2(sum[2] * rc - bf2f((bf16_t)(own.y & 0xffff)), sum[3] * rc - bf2f((bf16_t)(own.y >> 16)));
      pk.z = pack2(sum[4] * rc - bf2f((bf16_t)(own.z & 0xffff)), sum[5] * rc - bf2f((bf16_t)(own.z >> 16)));
      pk.w = pack2(sum[6] * rc - bf2f((bf16_t)(own.w & 0xffff)), sum[7] * rc - bf2f((bf16_t)(own.w >> 16)));
      const bf16x8 bq = __builtin_bit_cast(bf16x8, pk);
      const bf16_t* wp = (const bf16_t*)(ws + OFF_WPOOL) + (size_t)gp * 4096 + (size_t)l15 * 64 + 32 * ks + 8 * lg;
#pragma unroll
      for (int mt = 0; mt < 4; ++mt) acc[mt] = mfma16(ld16(wp + mt * 16 * 64), bq, acc[mt]);
    }
    const size_t off = (size_t)tok * 1024 + 512 + gp * 64 + 4 * lg;
    const bf16_t* zp = (const bf16_t*)(ws + OFF_ZS) + off;
    bf16_t* yp = (bf16_t*)(ws + OFF_Y) + off;
#pragma unroll
    for (int mt = 0; mt < 4; ++mt) {
      const float4 ps = *(const float4*)(P.pool_scale + gp * 64 + 16 * mt + 4 * lg);
      const uint2 zz = *(const uint2*)(zp + 16 * mt);
      st4bf(yp + 16 * mt, acc[mt][0] * ps.x * bf2f((bf16_t)(zz.x & 0xffff)), acc[mt][1] * ps.y * bf2f((bf16_t)(zz.x >> 16)),
            acc[mt][2] * ps.z * bf2f((bf16_t)(zz.y & 0xffff)), acc[mt][3] * ps.w * bf2f((bf16_t)(zz.y >> 16)));
    }
  }
  __syncthreads();
}

struct EpiIn {
  static constexpr bool PERM = false, AFTER_DRAIN = false;
  const Params* P;
  __device__ __forceinline__ void operator()(const f32x4 (&acc)[2][2][4][2], const pg8::Unit& u, int wr, int wc, int fr, int fq) const {
    const int ft = u.pn * 4 + wc;
#pragma unroll
    for (int ai = 0; ai < 2; ++ai) {
      f32x4 t[4][4];
#pragma unroll
      for (int mt = 0; mt < 4; ++mt)
#pragma unroll
        for (int m = 0; m < 4; ++m) t[mt][m] = acc[ai][mt >> 1][m][mt & 1];
      inproj_epilogue(*P, t, ft, u.pm * 256 + ai * 128 + wr * 64);
    }
  }
};
struct EpiMemKV {
  static constexpr bool PERM = false, AFTER_DRAIN = false;
  const Params* P;
  __device__ __forceinline__ void operator()(const f32x4 (&acc)[2][2][4][2], const pg8::Unit& u, int wr, int wc, int fr, int fq) const {
    const int ft = u.pn * 4 + wc;
#pragma unroll
    for (int ai = 0; ai < 2; ++ai) {
      f32x4 t[4][4];
#pragma unroll
      for (int mt = 0; mt < 4; ++mt)
#pragma unroll
        for (int m = 0; m < 4; ++m) t[mt][m] = acc[ai][mt >> 1][m][mt & 1];
      memkv_epilogue(*P, t, ft, u.pm * 256 + ai * 128 + wr * 64);
    }
  }
};
struct EpiOut {
  static constexpr bool PERM = false, AFTER_DRAIN = false;
  const float* x; float* out;
  __device__ __forceinline__ void operator()(const f32x4 (&acc)[2][2][4][2], const pg8::Unit& u, int wr, int wc, int fr, int fq) const {
    const int ln = otid() & 63;
    const int row0 = u.pm * 256 + wr * 64 + (ln & 15), col0 = u.pn * 256 + wc * 32 + 4 * (ln >> 4);
#pragma unroll
    for (int ai = 0; ai < 2; ++ai) {
      float4 xv[4][2][2];
#pragma unroll
      for (int m = 0; m < 4; ++m)
#pragma unroll
        for (int bj = 0; bj < 2; ++bj)
#pragma unroll
          for (int n = 0; n < 2; ++n)
            xv[m][bj][n] = *(const float4*)(x + (size_t)(row0 + ai * 128 + m * 16) * DM + col0 + bj * 128 + n * 16);
#pragma unroll
      for (int m = 0; m < 4; ++m)
#pragma unroll
        for (int bj = 0; bj < 2; ++bj)
#pragma unroll
          for (int n = 0; n < 2; ++n) {
            const size_t off = (size_t)(row0 + ai * 128 + m * 16) * DM + col0 + bj * 128 + n * 16;
            float4 r; r.x = xv[m][bj][n].x + acc[ai][bj][m][n][0]; r.y = xv[m][bj][n].y + acc[ai][bj][m][n][1];
            r.z = xv[m][bj][n].z + acc[ai][bj][m][n][2]; r.w = xv[m][bj][n].w + acc[ai][bj][m][n][3];
            ntstore4(out + off, r);
          }
    }
  }
};

__device__ unsigned g_bar[2];
typedef __attribute__((address_space(4))) const Params* KargPtr;
DI const Params& PP(const Params&) { KargPtr p = (KargPtr)__builtin_amdgcn_kernarg_segment_ptr(); asm volatile("" : "+s"(p)); return *(const Params*)p; }
DI void grid_barrier(unsigned* cnt, const unsigned target) {
  asm volatile("s_waitcnt vmcnt(0)" ::: "memory");
  __syncthreads();
  if (threadIdx.x == 0) {
    __builtin_amdgcn_fence(__ATOMIC_RELEASE, "agent");
    __hip_atomic_fetch_add(cnt, 1u, __ATOMIC_RELAXED, __HIP_MEMORY_SCOPE_AGENT);
    while (__hip_atomic_load(cnt, __ATOMIC_RELAXED, __HIP_MEMORY_SCOPE_AGENT) < target) __builtin_amdgcn_s_sleep(2);
    __builtin_amdgcn_fence(__ATOMIC_ACQUIRE, "agent");
  }
  __syncthreads();
}

__global__ void __launch_bounds__(512, 2) fwd_megakernel(Params P) {
  cg::grid_group grid = cg::this_grid();
  __shared__ __attribute__((aligned(16))) unsigned char smem[SM_TOTAL];
  __shared__ int s_item;
  const int tid = threadIdx.x;
  const int nblk = gridDim.x;
  int* counter = (int*)(P.ws + OFF_CNT);
  unsigned* gbar = &g_bar[0];
  if (P.out == nullptr) grid.sync();
  const unsigned nb = gridDim.x;

  if (blockIdx.x == 0 && tid < 16) counter[tid] = 0;
  if (blockIdx.x == 0 && tid >= 64 && tid < 68) {
    const int wch = tid - 64;
    const float* gq = (wch == 3) ? P.g_q_mem : P.g_q_nsa;
    const float* gk = (wch == 0) ? P.g_k_slc : (wch == 1) ? P.g_k_win : (wch == 2) ? P.g_k_cmp : P.g_k_mem;
    float mq = 0.f, mk = 0.f;
    for (int i = 0; i < 64; ++i) { mq = fmaxf(mq, fabsf(gq[i])); mk = fmaxf(mk, fabsf(gk[i])); }
    const float bound = 11.8f * mq * mk;
    ((float*)(P.ws + OFF_CNT + 128))[wch] = -fmaxf(0.f, bound - 64.f);
  }
  {
    constexpr int NTR = P0_NT / 2, NBI = 64, NROWIT = (NTOK + NMEMTOK) / 32;
    for (int it = blockIdx.x; it < NTR + NBI + NROWIT; it += nblk) {
      if (it < NTR) p0_transpose_pair(PP(P), it, smem);
      else if (it < NTR + NBI) p0_bias_pair(PP(P), it - NTR, smem);
      else { p0_row_norm2(PP(P), (it - NTR - NBI) * 32 + (tid >> 6) * 4); }
    }
  }
  grid_barrier(gbar, nb);
  {
    pg8::Gemm g; g.A = (const bf16_t*)(P.ws + OFF_XB); g.Bt = (const bf16_t*)(P.ws + OFF_WTIN); g.M = NTOK; g.N = NFP; g.K = DM;
    pg8::StaticOrder S; S.init(g.M, g.N, nblk, (int)blockIdx.x);
    EpiIn E; E.P = &PP(P);
    pg8::gemm_phase<EpiIn, pg8::StaticOrder, false>((PG8_LAS unsigned char*)smem, g, S, E, nullptr);
  }
  grid_barrier(gbar, 2 * nb);
  if (blockIdx.x < 128 || nblk < 144) {
    for (int it = blockIdx.x; it < 128; it += nblk) p2_compress_item(PP(P), it);
  }
  if (blockIdx.x >= 128 || nblk < 144) {
    pg8::Gemm g2; g2.A = (const bf16_t*)(P.ws + OFF_MH); g2.Bt = (const bf16_t*)(P.ws + OFF_WTMKV); g2.M = NMEMTOK; g2.N = 512; g2.K = DM;
    pg8::StaticOrder S2; S2.init(g2.M, g2.N, nblk, (int)((blockIdx.x + nblk - 128) % nblk));
    EpiMemKV E2; E2.P = &PP(P);
    __syncthreads();
    pg8::gemm_phase<EpiMemKV, pg8::StaticOrder, false>((PG8_LAS unsigned char*)smem, g2, S2, E2, nullptr);
  }
  grid_barrier(gbar, 3 * nb);
  {
    constexpr int NX_NSA = 256, NX_MEM = 128, NX_POOL = 64;
    for (int qi = 0; qi < 8; ++qi) {
      const int xq = (blockIdx.x + qi) & 7;
      for (;;) {
        __syncthreads();
        if (tid == 0) s_item = atomicAdd(counter + xq, 1);
        __syncthreads();
        const int it = s_item;
        if (it >= NX_NSA + NX_MEM + NX_POOL) break;
        if (it < NX_NSA) {
          p3_nsa_item(PP(P), 2 * xq + (it >> 7), 127 - (it & 127), smem);
        } else if (it < NX_NSA + NX_MEM) {
          const int i2 = it - NX_NSA;
          p3_mem_item(PP(P), 4 * xq + (i2 >> 5), i2 & 31, smem);
        } else {
          p3_pool_item(PP(P), xq * NX_POOL + (it - NX_NSA - NX_MEM), smem);
        }
      }
    }
  }
  grid_barrier(gbar, 4 * nb);
  {
    pg8::Gemm g; g.A = (const bf16_t*)(P.ws + OFF_Y); g.Bt = (const bf16_t*)(P.ws + OFF_WTOUT); g.M = NTOK; g.N = DM; g.K = DM;
    pg8::StaticOrder S; S.init(g.M, g.N, nblk, (int)blockIdx.x);
    const Params& P4 = PP(P);
    EpiOut E; E.x = P4.x; E.out = P4.out;
    pg8::gemm_phase<EpiOut, pg8::StaticOrder, false>((PG8_LAS unsigned char*)smem, g, S, E, nullptr);
  }
  if (tid == 0) {
    const unsigned old = __hip_atomic_fetch_add(&g_bar[1], 1u, __ATOMIC_RELAXED, __HIP_MEMORY_SCOPE_AGENT);
    if (old == nb - 1) { __hip_atomic_store(&g_bar[0], 0u, __ATOMIC_RELAXED, __HIP_MEMORY_SCOPE_AGENT); __hip_atomic_store(&g_bar[1], 0u, __ATOMIC_RELAXED, __HIP_MEMORY_SCOPE_AGENT); }
  }
}

extern "C" void kernel_launch(void* const* d_in, const int* in_sizes, int n_in,
                              void* d_out, int out_size, void* d_ws, size_t ws_size,
                              hipStream_t stream) {
  static int grid_blocks = 0;
  if (!grid_blocks) {
    int dev = 0, cus = 0, per_cu = 0;
    (void)hipGetDevice(&dev);
    (void)hipDeviceGetAttribute(&cus, hipDeviceAttributeMultiprocessorCount, dev);
    (void)hipOccupancyMaxActiveBlocksPerMultiprocessor(&per_cu, fwd_megakernel, 512, 0);
    if (per_cu > 1) per_cu = 1;
    if (per_cu < 1) per_cu = 1;
    grid_blocks = cus * per_cu;
  }
  if (ws_size < WS_NEED) { fprintf(stderr, "workspace too small: %zu < %zu\n", ws_size, (size_t)WS_NEED); return; }
  Params p{};
  p.x = (const float*)d_in[0]; p.mem = (const float*)d_in[1]; p.pos = (const int*)d_in[2];
  p.g_norm = (const float*)d_in[3]; p.w_in = (const float*)d_in[4]; p.g_q_nsa = (const float*)d_in[5];
  p.g_k_cmp = (const float*)d_in[6]; p.g_k_slc = (const float*)d_in[7]; p.g_k_win = (const float*)d_in[8];
  p.cmp_pos_k = (const float*)d_in[9]; p.w_cmp_k1 = (const float*)d_in[10]; p.w_cmp_k2 = (const float*)d_in[11];
  p.cmp_pos_v = (const float*)d_in[12]; p.w_cmp_v1 = (const float*)d_in[13]; p.w_cmp_v2 = (const float*)d_in[14];
  p.w_pool = (const float*)d_in[15]; p.pool_scale = (const float*)d_in[16]; p.g_mem = (const float*)d_in[17];
  p.w_mem_kv = (const float*)d_in[18]; p.g_q_mem = (const float*)d_in[19]; p.g_k_mem = (const float*)d_in[20];
  p.w_out = (const float*)d_in[21];
  p.out = (float*)d_out;
  p.ws = (unsigned char*)d_ws;
  void* args[] = {&p};
  hipError_t e = hipLaunchCooperativeKernel((void*)fwd_megakernel, dim3(grid_blocks), dim3(512), args, 0, stream);
  if (e != hipSuccess) fprintf(stderr, "cooperative launch failed: %s (grid %d)\n", hipGetErrorString(e), grid_blocks);
}
```

```cpp
#include <hip/hip_runtime.h>
#include <hip/hip_cooperative_groups.h>
#include <cstdio>
namespace cg = cooperative_groups;

#define DI __device__ __forceinline__
typedef unsigned short bf16_t;
typedef short bf16x8 __attribute__((ext_vector_type(8)));
typedef short s16x4 __attribute__((ext_vector_type(4)));
typedef float f32x4 __attribute__((ext_vector_type(4)));

#ifndef EN_POOL
#define EN_POOL 1
#endif
#ifndef EN_MEM
#define EN_MEM 1
#endif
#ifndef EN_NSA
#define EN_NSA 1
#endif
#ifndef EN_CMP
#define EN_CMP 1
#endif
#ifndef EN_SEL
#define EN_SEL 1
#endif
#ifndef EN_WIN
#define EN_WIN 1
#endif

constexpr int SEQ = 8192;
constexpr int NB = 8;
constexpr int NTOK = NB * SEQ;
constexpr int DM = 1024;
constexpr int INW = 2840;
constexpr int NFP = 3072;
constexpr int MEML = 256;
constexpr int NMEMTOK = NB * MEML;
constexpr int NCP = 512;

constexpr size_t al256(size_t x) { return (x + 255) & ~(size_t)255; }
constexpr size_t OFF_XB    = 0;
constexpr size_t OFF_WTIN  = OFF_XB    + al256((size_t)NTOK * DM * 2);
constexpr size_t OFF_WTOUT = OFF_WTIN  + al256((size_t)NFP * DM * 2);
constexpr size_t OFF_MH    = OFF_WTOUT + al256((size_t)DM * DM * 2);
constexpr size_t OFF_WTMKV = OFF_MH    + al256((size_t)NMEMTOK * DM * 2);
constexpr size_t OFF_WC1K  = OFF_WTMKV + al256((size_t)512 * DM * 2);
constexpr size_t OFF_WC1V  = OFF_WC1K  + al256((size_t)64 * 2048 * 2);
constexpr size_t OFF_WC2K  = OFF_WC1V  + al256((size_t)64 * 2048 * 2);
constexpr size_t OFF_WC2V  = OFF_WC2K  + al256((size_t)64 * 64 * 2);
constexpr size_t OFF_WPOOL = OFF_WC2V  + al256((size_t)64 * 64 * 2);
constexpr size_t OFF_BIASC = OFF_WPOOL + al256((size_t)4 * 64 * 64 * 2);
constexpr size_t OFF_ROPE  = OFF_BIASC + al256((size_t)128 * 4);
constexpr size_t OFF_QN    = OFF_ROPE  + al256((size_t)NTOK * 16 * 4);
constexpr size_t OFF_KCRAW = OFF_QN    + al256((size_t)NTOK * 512 * 2);
constexpr size_t OFF_VCRAW = OFF_KCRAW + al256((size_t)NTOK * 128 * 2);
constexpr size_t OFF_KS    = OFF_VCRAW + al256((size_t)NTOK * 128 * 2);
constexpr size_t OFF_VST   = OFF_KS    + al256((size_t)NTOK * 128 * 2);
constexpr size_t OFF_KW    = OFF_VST   + al256((size_t)NTOK * 128 * 2);
constexpr size_t OFF_VWT   = OFF_KW    + al256((size_t)NTOK * 128 * 2);
constexpr size_t OFF_ZS    = OFF_VWT   + al256((size_t)NTOK * 128 * 2);
constexpr size_t OFF_VP    = OFF_ZS    + al256((size_t)NTOK * 1024 * 2);
constexpr size_t OFF_QM    = OFF_VP    + al256((size_t)NTOK * 256 * 2);
constexpr size_t OFF_GATES = OFF_QM    + al256((size_t)NTOK * 256 * 2);
constexpr size_t OFF_KC    = OFF_GATES + al256((size_t)NTOK * 24 * 4);
constexpr size_t OFF_VCT   = OFF_KC    + al256((size_t)16 * NCP * 64 * 2);
constexpr size_t OFF_MK    = OFF_VCT   + al256((size_t)16 * 64 * NCP * 2);
constexpr size_t OFF_MVT   = OFF_MK    + al256((size_t)32 * MEML * 64 * 2);
constexpr size_t OFF_Y     = OFF_MVT   + al256((size_t)32 * 64 * MEML * 2);
constexpr size_t OFF_CNT   = OFF_Y     + al256((size_t)NTOK * 1024 * 2);
constexpr size_t WS_NEED   = OFF_CNT   + 512;

struct Params {
  const float* x; const float* mem; const int* pos;
  const float* g_norm; const float* w_in; const float* g_q_nsa; const float* g_k_cmp; const float* g_k_slc; const float* g_k_win;
  const float* cmp_pos_k; const float* w_cmp_k1; const float* w_cmp_k2; const float* cmp_pos_v; const float* w_cmp_v1; const float* w_cmp_v2;
  const float* w_pool; const float* pool_scale; const float* g_mem; const float* w_mem_kv; const float* g_q_mem; const float* g_k_mem; const float* w_out;
  float* out;
  unsigned char* ws;
};

DI float4 ntload4(const float* p) { f32x4 v = __builtin_nontemporal_load((const f32x4*)p); return make_float4(v[0], v[1], v[2], v[3]); }
DI void ntstore4(float* p, float4 r) { f32x4 v = {r.x, r.y, r.z, r.w}; __builtin_nontemporal_store(v, (f32x4*)p); }
DI int otid() { int t = threadIdx.x; asm volatile("" : "+v"(t)); return t; }
DI bf16_t f2bf(float f) { unsigned u = __float_as_uint(f); u += 0x7fffu + ((u >> 16) & 1u); return (bf16_t)(u >> 16); }
DI float bf2f(bf16_t h) { return __uint_as_float(((unsigned)h) << 16); }
typedef __bf16 hwbf2 __attribute__((ext_vector_type(2)));
typedef float f32x2 __attribute__((ext_vector_type(2)));
DI unsigned pack2(float a, float b) { f32x2 v = {a, b}; hwbf2 r = __builtin_convertvector(v, hwbf2); return __builtin_bit_cast(unsigned, r); }
DI float ex2(float x) { return __builtin_amdgcn_exp2f(x); }
DI f32x4 mfma16(bf16x8 a, bf16x8 b, f32x4 c) { return __builtin_amdgcn_mfma_f32_16x16x32_bf16(a, b, c, 0, 0, 0); }
DI float shx(float v, int m) { return __shfl_xor(v, m, 64); }
#define DPP_I(v, ctrl) __builtin_amdgcn_update_dpp(0, (v), (ctrl), 0xF, 0xF, false)
DI int   dpp_x1(int v)   { return DPP_I(v, 0xB1); }
DI int   dpp_x2(int v)   { return DPP_I(v, 0x4E); }
DI int   dpp_hm(int v)   { return DPP_I(v, 0x141); }
DI float dpp_x1f(float v) { return __builtin_bit_cast(float, dpp_x1(__builtin_bit_cast(int, v))); }
DI float dpp_x2f(float v) { return __builtin_bit_cast(float, dpp_x2(__builtin_bit_cast(int, v))); }
DI float silu_f(float z) { return z * __builtin_amdgcn_rcpf(1.f + __builtin_amdgcn_exp2f(-1.4426950408889634f * z)); }
DI float sigmoid_f(float z) { return __builtin_amdgcn_rcpf(1.f + __builtin_amdgcn_exp2f(-1.4426950408889634f * z)); }
DI float gelu_tanh(float x) {
  float u = 0.7978845608028654f * (x + 0.044715f * x * x * x);
  float t = 1.f - 2.f * __builtin_amdgcn_rcpf(__builtin_amdgcn_exp2f(2.8853900817779268f * u) + 1.f);
  return 0.5f * x * (1.f + t);
}
DI bf16x8 pack8(f32x4 a, f32x4 b) {
  uint4 p; p.x = pack2(a[0], a[1]); p.y = pack2(a[2], a[3]); p.z = pack2(b[0], b[1]); p.w = pack2(b[2], b[3]);
  return __builtin_bit_cast(bf16x8, p);
}
DI bf16x8 ld16(const void* p) { return *(const bf16x8*)p; }
DI bf16x8 ld8x2(const void* p0, const void* p1) {
  uint2 a = *(const uint2*)p0; uint2 b = *(const uint2*)p1;
  uint4 r; r.x = a.x; r.y = a.y; r.z = b.x; r.w = b.y;
  return __builtin_bit_cast(bf16x8, r);
}
DI void st4bf(bf16_t* dst, float a, float b, float c, float d) {
  uint2 v; v.x = pack2(a, b); v.y = pack2(c, d); *(uint2*)dst = v;
}

DI void p0_row_norm(const Params& P, int row) {
  const int lane = otid() & 63;
  const bool is_x = row < NTOK;
  const float* src = is_x ? (P.x + (size_t)row * DM) : (P.mem + (size_t)(row - NTOK) * DM);
  bf16_t* dst = is_x ? ((bf16_t*)(P.ws + OFF_XB) + (size_t)row * DM) : ((bf16_t*)(P.ws + OFF_MH) + (size_t)(row - NTOK) * DM);
  float4 v[4];
  float ss = 0.f;
#pragma unroll
  for (int u = 0; u < 4; ++u) {
    v[u] = *(const float4*)(src + lane * 4 + 256 * u);
    ss += v[u].x * v[u].x + v[u].y * v[u].y + v[u].z * v[u].z + v[u].w * v[u].w;
  }
#pragma unroll
  for (int m = 32; m >= 1; m >>= 1) ss += shx(ss, m);
  const float rinv = rsqrtf(ss * (1.f / 1024.f) + 1e-6f);
#pragma unroll
  for (int u = 0; u < 4; ++u) st4bf(dst + lane * 4 + 256 * u, v[u].x * rinv, v[u].y * rinv, v[u].z * rinv, v[u].w * rinv);
  if (is_x && lane < 8) {
    float invf = 1.0f;
    if (lane == 1) invf = 0.19392274f; else if (lane == 2) invf = 0.03760603f; else if (lane == 3) invf = 0.0072926646f;
    else if (lane == 4) invf = 0.0014142136f; else if (lane == 5) invf = 0.0002742482f; else if (lane == 6) invf = 5.3182957e-05f;
    else if (lane == 7) invf = 1.0313385e-05f;
    const float ang = (float)P.pos[row] * invf;
    const double a = (double)ang;
    const double k = rint(a * 0.15915494309189535);
    const float r = (float)(a - k * 6.283185307179586);
    float* rt = (float*)(P.ws + OFF_ROPE) + (size_t)row * 16;
    rt[lane] = cosf(r);
    rt[8 + lane] = sinf(r);
  }
}

DI void p0_row_norm2(const Params& P, int row) {
  const int lane = otid() & 63;
  const bool is_x = row < NTOK;
  const float* src = is_x ? (P.x + (size_t)row * DM) : (P.mem + (size_t)(row - NTOK) * DM);
  bf16_t* dst = is_x ? ((bf16_t*)(P.ws + OFF_XB) + (size_t)row * DM) : ((bf16_t*)(P.ws + OFF_MH) + (size_t)(row - NTOK) * DM);
  float4 v[8][4];
#pragma unroll
  for (int r = 0; r < 8; ++r)
#pragma unroll
    for (int u = 0; u < 4; ++u) v[r][u] = ntload4(src + r * DM + lane * 4 + 256 * u);
#pragma unroll
  for (int r = 0; r < 8; ++r) {
    float ss = 0.f;
#pragma unroll
    for (int u = 0; u < 4; ++u) ss += v[r][u].x * v[r][u].x + v[r][u].y * v[r][u].y + v[r][u].z * v[r][u].z + v[r][u].w * v[r][u].w;
#pragma unroll
    for (int m = 32; m >= 1; m >>= 1) ss += shx(ss, m);
    const float rinv = rsqrtf(ss * (1.f / 1024.f) + 1e-6f);
#pragma unroll
    for (int u = 0; u < 4; ++u) st4bf(dst + r * DM + lane * 4 + 256 * u, v[r][u].x * rinv, v[r][u].y * rinv, v[r][u].z * rinv, v[r][u].w * rinv);
  }
  if (is_x) {
    const int fi = lane & 7, rr = row + (lane >> 3);
    float invf = 1.0f;
    if (fi == 1) invf = 0.19392274f; else if (fi == 2) invf = 0.03760603f; else if (fi == 3) invf = 0.0072926646f;
    else if (fi == 4) invf = 0.0014142136f; else if (fi == 5) invf = 0.0002742482f; else if (fi == 6) invf = 5.3182957e-05f;
    else if (fi == 7) invf = 1.0313385e-05f;
    const float ang = (float)P.pos[rr] * invf;
    const double a = (double)ang;
    const double k = rint(a * 0.15915494309189535);
    const float r = (float)(a - k * 6.283185307179586);
    float* rt = (float*)(P.ws + OFF_ROPE) + (size_t)rr * 16;
    rt[fi] = cosf(r);
    rt[8 + fi] = sinf(r);
  }
}

struct TrJob { const float* src; int src_ld, k0, fsrc0, nvalid; bf16_t* dst; int dst_ld, fdst0; const float* scale; int split; };
DI void p0_transpose_tile(const TrJob& j, bool valid, int tid, unsigned char* smem) {
  float* tile = (float*)smem;
  const int r = tid >> 4, c4 = (tid & 15) * 4;
  if (valid) {
#pragma unroll
    for (int ps = 0; ps < 4; ++ps) {
      const int k = r + 16 * ps;
      float4 v = make_float4(0.f, 0.f, 0.f, 0.f);
      if (c4 < j.nvalid) v = *(const float4*)(j.src + (size_t)(j.k0 + k) * j.src_ld + j.fsrc0 + c4);
      const float sc = j.scale ? j.scale[j.k0 + k] : 1.f;
      tile[(c4 + 0) * 65 + k] = v.x * sc; tile[(c4 + 1) * 65 + k] = v.y * sc;
      tile[(c4 + 2) * 65 + k] = v.z * sc; tile[(c4 + 3) * 65 + k] = v.w * sc;
    }
  }
  __syncthreads();
  if (valid) {
    const int f = tid >> 2, kc = (tid & 3) * 16;
    const int row = j.split ? (j.fdst0 + (f & 31) + 128 * (f >> 5)) : (j.fdst0 + f);
    bf16_t* d = j.dst + (size_t)row * j.dst_ld + j.k0 + kc;
#pragma unroll
    for (int q = 0; q < 4; ++q) st4bf(d + 4 * q, tile[f * 65 + kc + 4 * q], tile[f * 65 + kc + 4 * q + 1], tile[f * 65 + kc + 4 * q + 2], tile[f * 65 + kc + 4 * q + 3]);
  }
  __syncthreads();
}
constexpr int P0_NT = 768 + 256 + 128 + 32 + 32 + 2 + 4;

DI TrJob p0_job(const Params& P, int t) {
  unsigned char* ws = P.ws;
  TrJob j{};
  j.src_ld = 64; j.nvalid = 64; j.dst_ld = 64;
  if (t < 768) {
    const int ft = t % 48, kt = t / 48;
    j.src = P.w_in; j.src_ld = INW; j.k0 = kt * 64; j.scale = P.g_norm; j.dst = (bf16_t*)(ws + OFF_WTIN); j.dst_ld = DM; j.split = 1;
    j.fdst0 = (ft >> 2) * 256 + (ft & 3) * 32;
    if (ft < 20) j.fsrc0 = ft * 64; else if (ft < 44) j.fsrc0 = 1304 + (ft - 20) * 64; else { j.fsrc0 = 1280; j.nvalid = (ft == 44) ? 24 : 0; }
    return j;
  }
  t -= 768;
  if (t < 256) { j.src = P.w_out; j.src_ld = DM; j.k0 = (t >> 4) * 64; j.fsrc0 = (t & 15) * 64; j.dst = (bf16_t*)(ws + OFF_WTOUT); j.dst_ld = DM; j.fdst0 = (t & 15) * 64; return j; }
  t -= 256;
  if (t < 128) { const int ft = t & 7; j.src = P.w_mem_kv; j.src_ld = 512; j.k0 = (t >> 3) * 64; j.fsrc0 = ft * 64; j.scale = P.g_mem; j.dst = (bf16_t*)(ws + OFF_WTMKV); j.dst_ld = DM;
                 j.split = 1; j.fdst0 = (ft >> 2) * 256 + (ft & 3) * 32; return j; }
  t -= 128;
  if (t < 32) { j.src = P.w_cmp_k1; j.k0 = t * 64; j.dst = (bf16_t*)(ws + OFF_WC1K); j.dst_ld = 2048; return j; }
  t -= 32;
  if (t < 32) { j.src = P.w_cmp_v1; j.k0 = t * 64; j.dst = (bf16_t*)(ws + OFF_WC1V); j.dst_ld = 2048; return j; }
  t -= 32;
  if (t == 0) { j.src = P.w_cmp_k2; j.dst = (bf16_t*)(ws + OFF_WC2K); return j; }
  if (t == 1) { j.src = P.w_cmp_v2; j.dst = (bf16_t*)(ws + OFF_WC2V); return j; }
  t -= 2;
  j.src = P.w_pool + (size_t)t * 4096; j.dst = (bf16_t*)(ws + OFF_WPOOL) + (size_t)t * 4096;
  return j;
}
DI void p0_transpose_pair(const Params& P, int it, unsigned char* smem) {
  const int tid = otid(), half = tid >> 8;
  const int t = 2 * it + half;
  const bool valid = t < P0_NT;
  const TrJob j = p0_job(P, valid ? t : 0);
  p0_transpose_tile(j, valid, tid & 255, smem + half * 17408);
}

DI void p0_bias_pair(const Params& P, int it2, unsigned char* smem) {
  const int tid0 = otid(), half = tid0 >> 8, tid = tid0 & 255, it = 2 * it2 + half;
  const int which = it >> 6, e = it & 63;
  const float* pe = which ? P.cmp_pos_v : P.cmp_pos_k;
  const float* w1 = which ? P.w_cmp_v1 : P.w_cmp_k1;
  float s = 0.f;
  for (int k = tid; k < 2048; k += 256) s += pe[k] * w1[(size_t)k * 64 + e];
#pragma unroll
  for (int m = 32; m >= 1; m >>= 1) s += shx(s, m);
  float* red = (float*)smem + half * 8;
  __syncthreads();
  if ((tid & 63) == 0) red[tid >> 6] = s;
  __syncthreads();
  if (tid == 0) ((float*)(P.ws + OFF_BIASC))[it] = red[0] + red[1] + red[2] + red[3];
  __syncthreads();
}

namespace pg8 {
#define PG8_LAS __attribute__((address_space(3)))
typedef unsigned short bf16_t;
typedef short bf16x8 __attribute__((ext_vector_type(8)));
typedef float f32x4 __attribute__((ext_vector_type(4)));
typedef unsigned u32x4 __attribute__((ext_vector_type(4)));
constexpr int BM = 256, BK = 64, HALF = 128, HTB = HALF * BK * 2  , STAGE_BYTES = 8 * HTB, NXCD = 8, WGM = 8;

__host__ __device__ __forceinline__ int lds_byte(int r, int c) { const int st = (r >> 4) * 2 + (c >> 5), rr = r & 15, cc = c & 31, ob = rr * 64 + cc * 2; return st * 1024 + (ob ^ (((ob >> 9) & 1) << 5)); }
__host__ __device__ __forceinline__ void stage_rc(int b, int& R, int& C) { const int st = b / 1024, sb = b % 1024, swz = sb ^ (((sb >> 9) & 1) << 5); R = (st >> 1) * 16 + swz / 64; C = (st & 1) * 32 + (swz % 64) / 2; }
__host__ __device__ __forceinline__ int perm32(int rho) { const int n = rho >> 4, i = rho & 15; return 8 * (i >> 2) + 4 * n + (i & 3); }

struct Unit { int pm, pn; };
struct Gemm { const bf16_t* A; const bf16_t* Bt; int M, N, K; };

struct StaticOrder {
    int nM, nN, nwg, G, c;
    __host__ __device__ void init(int M, int N, int G_, int c_) { nM = M / BM; nN = N / BM; nwg = nM * nN; G = G_; c = c_; }
    __host__ __device__ bool next(int i, Unit& u) const {
        const long L = (long)i * G + c; if (L >= nwg) return false;
        int wgid = (int)L; { const int q = nwg / NXCD, r = nwg % NXCD, xcd = wgid % NXCD, off = wgid / NXCD; wgid = (xcd < r ? xcd * (q + 1) : r * (q + 1) + (xcd - r) * q) + off; }
        const int nig = WGM * nN, gid = wgid / nig, fm = gid * WGM, gsz = (nM - fm) < WGM ? (nM - fm) : WGM;
        u.pm = fm + ((wgid % nig) % gsz); u.pn = (wgid % nig) / gsz; return true;
    }
    __device__ __forceinline__ void a_ready(const Unit&) const {}
    __device__ __forceinline__ void done(const Unit&) const {}
};
template <class Epi, class Sched, bool STAMP = false>
__device__ __forceinline__ void gemm_phase(PG8_LAS unsigned char* lds, const Gemm g, const Sched& S, const Epi& E, unsigned long long* stamps) {
    const int tid = otid(), wid = __builtin_amdgcn_readfirstlane(tid >> 6), lane = tid & 63, wr = wid >> 2, wc = wid & 3, fr = lane & 15, fq = lane >> 4;
    const int K = g.K, nt = K / BK;
    int ts_lo = 0, ts_hi = 0, nts = 0; const unsigned long long rt_entry = STAMP ? (unsigned long long)wall_clock64() : 0ull;
#define PG8_STAMP() do { if (STAMP && wid == 0 && nts < 64) { const unsigned long long _c = (unsigned long long)clock64(); \
        ts_lo = (lane == nts) ? (int)(unsigned)_c : ts_lo; ts_hi = (lane == nts) ? (int)(unsigned)(_c >> 32) : ts_hi; ++nts; } } while (0)
    PG8_STAMP();
    unsigned voffA[2], voffB[2];
#pragma unroll
    for (int i = 0; i < 2; ++i) { int R, C; stage_rc(tid * 16 + i * 8192, R, C); const int Rb = Epi::PERM ? ((R & ~31) + perm32(R & 31)) : R;
        voffA[i] = (unsigned)(R * K + C) * 2u; voffB[i] = (unsigned)(Rb * K + C) * 2u; }
    const size_t kstep = (size_t)(BK * 2);
    const size_t hstep = (size_t)HALF * K * 2;
    const size_t tstep = 2 * hstep;
    const unsigned ldsw = (unsigned)wid * 1024u;
    const int aoff = lds_byte(wr * 64 + fr, fq * 8), boff = lds_byte(wc * 32 + fr, fq * 8);
#define PG8_SA(b, h) (((b) * 2 + (h)) * HTB)
#define PG8_SB(b, h) ((4 + (b) * 2 + (h)) * HTB)
#define PG8_STAGE(bufoff, gbase, voff) do { _Pragma("unroll") for (int _i = 0; _i < 2; ++_i) \
        __builtin_amdgcn_global_load_lds((const unsigned*)((const char*)(gbase) + (voff)[_i]), (PG8_LAS unsigned*)(lds + (bufoff) + ldsw + _i * 8192), 16, 0, 0); } while (0)
#define PG8_LDA(dst, b, h) do { _Pragma("unroll") for (int m = 0; m < 4; ++m) _Pragma("unroll") for (int k = 0; k < 2; ++k) dst[m][k] = *(const PG8_LAS bf16x8*)(lds + PG8_SA(b, h) + aoff + m * 2048 + k * 1024); } while (0)
#define PG8_LDB(dst, b, h) do { _Pragma("unroll") for (int n = 0; n < 2; ++n) _Pragma("unroll") for (int k = 0; k < 2; ++k) dst[n][k] = *(const PG8_LAS bf16x8*)(lds + PG8_SB(b, h) + boff + n * 2048 + k * 1024); } while (0)
#define PG8_MMA(ai, bj, At, Bt) do { __builtin_amdgcn_s_setprio(1); _Pragma("unroll") for (int m = 0; m < 4; ++m) _Pragma("unroll") for (int n = 0; n < 2; ++n) _Pragma("unroll") for (int k = 0; k < 2; ++k) \
        acc[ai][bj][m][n] = __builtin_amdgcn_mfma_f32_16x16x32_bf16(Bt[n][k], At[m][k], acc[ai][bj][m][n], 0, 0, 0); __builtin_amdgcn_s_setprio(0); } while (0)
#define PG8_WAIT_V(n) asm volatile("s_waitcnt vmcnt(" #n ")" ::: "memory")
#define PG8_WAIT_L(n) asm volatile("s_waitcnt lgkmcnt(" #n ")" ::: "memory")
#define PG8_BAR __builtin_amdgcn_s_barrier()
#define PG8_SCHED __builtin_amdgcn_sched_barrier(0)
    Unit cur, nxt; int ui = 0;
    if (!S.next(0, cur)) return;
    f32x4 acc[2][2][4][2];
#pragma unroll
    for (int a = 0; a < 2; ++a)
#pragma unroll
        for (int b = 0; b < 2; ++b)
#pragma unroll
            for (int m = 0; m < 4; ++m)
#pragma unroll
                for (int n = 0; n < 2; ++n) acc[a][b][m][n] = (f32x4){0.f, 0.f, 0.f, 0.f};
    bf16x8 At[4][2], B0[2][2], B1[2][2];
    const char* cA = (const char*)g.A + (size_t)cur.pm * tstep; const char* cB = (const char*)g.Bt + (size_t)cur.pn * tstep;
    S.a_ready(cur);
    PG8_STAGE(PG8_SB(0, 0), cB, voffB); PG8_STAGE(PG8_SA(0, 0), cA, voffA); PG8_STAGE(PG8_SB(0, 1), cB + hstep, voffB); PG8_STAGE(PG8_SA(0, 1), cA + hstep, voffA);
    if (wr == 1) PG8_BAR;
    PG8_WAIT_V(4); PG8_BAR;
    PG8_STAGE(PG8_SB(1, 0), cB + kstep, voffB); PG8_STAGE(PG8_SA(1, 0), cA + kstep, voffA); PG8_STAGE(PG8_SB(1, 1), cB + hstep + kstep, voffB);
    PG8_WAIT_V(6); PG8_BAR;
    PG8_STAMP();
    for (;;) {
        const bool has_next = S.next(ui + 1, nxt);
        const char* nA = has_next ? (const char*)g.A + (size_t)nxt.pm * tstep : cA; const char* nB = has_next ? (const char*)g.Bt + (size_t)nxt.pn * tstep : cB;
        for (int t = 0; t < nt; t += 2) {
            const bool last = (t == nt - 2);
            const char* a1 = cA + (size_t)(t + 1) * kstep;
            const char* a2 = last ? nA : cA + (size_t)(t + 2) * kstep; const char* b2 = last ? nB : cB + (size_t)(t + 2) * kstep;
            const char* a3 = a2 + kstep; const char* b3 = b2 + kstep;
            if (last && has_next) S.a_ready(nxt);
            PG8_LDB(B0, 0, 0); PG8_SCHED; PG8_LDA(At, 0, 0); PG8_STAGE(PG8_SA(1, 1), a1 + hstep, voffA);
            PG8_WAIT_L(8); PG8_BAR; PG8_WAIT_L(0); PG8_MMA(0, 0, At, B0); PG8_BAR; PG8_SCHED;
            PG8_LDB(B1, 0, 1); PG8_STAGE(PG8_SB(0, 0), b2, voffB);
            PG8_BAR; PG8_WAIT_L(0); PG8_MMA(0, 1, At, B1); PG8_BAR;
            PG8_LDA(At, 0, 1); PG8_STAGE(PG8_SA(0, 0), a2, voffA);
            PG8_BAR; PG8_WAIT_L(0); PG8_MMA(1, 0, At, B0); PG8_BAR; PG8_SCHED;
            PG8_STAGE(PG8_SB(0, 1), b2 + hstep, voffB);
            PG8_WAIT_V(6); PG8_BAR; PG8_MMA(1, 1, At, B1); PG8_BAR;
            PG8_LDB(B0, 1, 0); PG8_SCHED; PG8_LDA(At, 1, 0); PG8_STAGE(PG8_SA(0, 1), a2 + hstep, voffA);
            PG8_WAIT_L(8); PG8_BAR; PG8_WAIT_L(0); PG8_MMA(0, 0, At, B0); PG8_BAR; PG8_SCHED;
            PG8_LDB(B1, 1, 1); PG8_STAGE(PG8_SB(1, 0), b3, voffB);
            PG8_BAR; PG8_WAIT_L(0); PG8_MMA(0, 1, At, B1); PG8_BAR;
            PG8_LDA(At, 1, 1); PG8_STAGE(PG8_SA(1, 0), a3, voffA);
            PG8_BAR; PG8_WAIT_L(0); PG8_MMA(1, 0, At, B0); PG8_BAR; PG8_SCHED;
            PG8_STAGE(PG8_SB(1, 1), b3 + hstep, voffB);
            PG8_WAIT_V(6); PG8_BAR; PG8_MMA(1, 1, At, B1); PG8_BAR;
        }
        PG8_STAMP();
        if constexpr (!Epi::AFTER_DRAIN) { E(acc, cur, wr, wc, fr, fq); S.done(cur); }
        PG8_STAMP();
        if (!has_next) break;
#pragma unroll
        for (int a = 0; a < 2; ++a)
#pragma unroll
            for (int b = 0; b < 2; ++b)
#pragma unroll
                for (int m = 0; m < 4; ++m)
#pragma unroll
                    for (int n = 0; n < 2; ++n) acc[a][b][m][n] = (f32x4){0.f, 0.f, 0.f, 0.f};
        cur = nxt; cA = nA; cB = nB; ++ui;
    }
    PG8_WAIT_V(0);
    if (wr == 0) PG8_BAR;
    PG8_BAR;
    if constexpr (Epi::AFTER_DRAIN) { E.fused(acc, cur, wr, wc, fr, fq, lds, wid, lane); S.done(cur); }
    PG8_STAMP();
    if (STAMP && wid == 0) { stamps[lane] = lane < nts ? (((unsigned long long)(unsigned)ts_hi << 32) | (unsigned)ts_lo) : 0ull;
        if (lane == 62) stamps[62] = rt_entry; if (lane == 63) stamps[63] = (unsigned long long)wall_clock64(); }
#undef PG8_STAMP
#undef PG8_SA
#undef PG8_SB
#undef PG8_STAGE
#undef PG8_LDA
#undef PG8_LDB
#undef PG8_MMA
#undef PG8_WAIT_V
#undef PG8_WAIT_L
#undef PG8_BAR
#undef PG8_SCHED
}
}

DI void head_norm_rope(f32x4 (&acc)[4][4], const float* gain, const float* ropeT, int tok0, bool rope, float outscale) {
  const int lane = otid() & 63, l15 = lane & 15, lg = lane >> 4;
  float gn[4][4];
#pragma unroll
  for (int mt = 0; mt < 4; ++mt) { float4 g4 = *(const float4*)(gain + 16 * mt + 4 * lg); gn[mt][0] = g4.x; gn[mt][1] = g4.y; gn[mt][2] = g4.z; gn[mt][3] = g4.w; }
#pragma unroll
  for (int nt = 0; nt < 4; ++nt) {
    float ss = 0.f;
#pragma unroll
    for (int mt = 0; mt < 4; ++mt)
#pragma unroll
      for (int i = 0; i < 4; ++i) ss += acc[mt][nt][i] * acc[mt][nt][i];
    ss += shx(ss, 16); ss += shx(ss, 32);
    const float rinv = rsqrtf(ss * (1.f / 64.f) + 1e-6f);
#pragma unroll
    for (int mt = 0; mt < 4; ++mt)
#pragma unroll
      for (int i = 0; i < 4; ++i) acc[mt][nt][i] = acc[mt][nt][i] * rinv * gn[mt][i];
    if (rope) {
      const float* rt = ropeT + (size_t)(tok0 + 16 * nt + l15) * 16 + 4 * (lg & 1);
      const float4 c4 = *(const float4*)rt, s4 = *(const float4*)(rt + 8);
      const float cs[4] = {c4.x, c4.y, c4.z, c4.w}, sn[4] = {s4.x, s4.y, s4.z, s4.w};
#pragma unroll
      for (int i = 0; i < 4; ++i) {
        const float own = acc[0][nt][i];
        const float oth = shx(own, 32);
        acc[0][nt][i] = (lg < 2) ? (own * cs[i] - oth * sn[i]) : (oth * sn[i] + own * cs[i]);
      }
    }
#pragma unroll
    for (int mt = 0; mt < 4; ++mt)
#pragma unroll
      for (int i = 0; i < 4; ++i) acc[mt][nt][i] *= outscale;
  }
}

DI void store_rowmajor(const f32x4 (&acc)[4][4], bf16_t* dst, size_t ld) {
  const int lane = otid() & 63, l15 = lane & 15, lg = lane >> 4, odd = lg & 1;
#pragma unroll
  for (int p = 0; p < 2; ++p) {
    bf16_t* rowp = dst + (size_t)(16 * (2 * p + odd) + l15) * ld + 4 * (lg - odd);
#pragma unroll
    for (int mt = 0; mt < 4; ++mt) {
      unsigned ax = pack2(acc[mt][2 * p][0], acc[mt][2 * p][1]), ay = pack2(acc[mt][2 * p][2], acc[mt][2 * p][3]);
      unsigned bx = pack2(acc[mt][2 * p + 1][0], acc[mt][2 * p + 1][1]), by = pack2(acc[mt][2 * p + 1][2], acc[mt][2 * p + 1][3]);
      const auto r0 = __builtin_amdgcn_permlane16_swap(ax, bx, false, false);
      const auto r1 = __builtin_amdgcn_permlane16_swap(ay, by, false, false);
      uint4 v; v.x = r0[0]; v.y = r1[0]; v.z = r0[1]; v.w = r1[1];
      *(uint4*)(rowp + 16 * mt) = v;
    }
  }
}
DI void store_transposed(const f32x4 (&acc)[4][4], bf16_t* dst, size_t ld) {
  const int lane = otid() & 63, l15 = lane & 15, lg = lane >> 4;
#pragma unroll
  for (int nt = 0; nt < 4; ++nt)
#pragma unroll
    for (int mt = 0; mt < 4; ++mt)
#pragma unroll
      for (int i = 0; i < 4; ++i) dst[(size_t)(16 * mt + 4 * lg + i) * ld + 32 * (nt >> 1) + (l15 >> 2) * 8 + (nt & 1) * 4 + (l15 & 3)] = f2bf(acc[mt][nt][i]);
}

DI void inproj_epilogue(const Params& P, f32x4 (&acc)[4][4], const int ft, const int tok0) {
  unsigned char* ws = P.ws;
  const int lane = otid() & 63, l15 = lane & 15, lg = lane >> 4;
  const int b = tok0 >> 13, s0 = tok0 & (SEQ - 1);
  const float* ropeT = (const float*)(ws + OFF_ROPE);
  if (ft < 8) {
    head_norm_rope(acc, P.g_q_nsa, ropeT, tok0, true, 0.18033688011112042f);
    store_rowmajor(acc, (bf16_t*)(ws + OFF_QN) + ((size_t)(b * 8 + ft) * SEQ + s0) * 64, 64);
  } else if (ft < 20) {
    const int idx = (ft - 8) >> 1, gi = (ft - 8) & 1;
    const size_t rm = ((size_t)(b * 2 + gi) * SEQ + s0) * 64;
    const size_t tr = (size_t)(b * 2 + gi) * 64 * SEQ + s0;
    if (idx == 0) store_rowmajor(acc, (bf16_t*)(ws + OFF_KCRAW) + rm, 64);
    else if (idx == 1) store_rowmajor(acc, (bf16_t*)(ws + OFF_VCRAW) + rm, 64);
    else if (idx == 2) { head_norm_rope(acc, P.g_k_slc, ropeT, tok0, true, 1.f); store_rowmajor(acc, (bf16_t*)(ws + OFF_KS) + rm, 64); }
    else if (idx == 3) store_transposed(acc, (bf16_t*)(ws + OFF_VST) + tr, SEQ);
    else if (idx == 4) { head_norm_rope(acc, P.g_k_win, ropeT, tok0, true, 1.f); store_rowmajor(acc, (bf16_t*)(ws + OFF_KW) + rm, 64); }
    else store_transposed(acc, (bf16_t*)(ws + OFF_VWT) + tr, SEQ);
  } else if (ft < 28 || (ft >= 32 && ft < 36) || (ft >= 40 && ft < 44)) {
    const int zoff = (ft < 28) ? (ft - 20) * 64 : (ft < 36 ? 512 + (ft - 32) * 64 : 768 + (ft - 40) * 64);
#pragma unroll
    for (int mt = 0; mt < 4; ++mt)
#pragma unroll
      for (int nt = 0; nt < 4; ++nt)
#pragma unroll
        for (int i = 0; i < 4; ++i) acc[mt][nt][i] = silu_f(acc[mt][nt][i]);
    store_rowmajor(acc, (bf16_t*)(ws + OFF_ZS) + (size_t)tok0 * 1024 + zoff, 1024);
  } else if (ft < 32) {
    store_rowmajor(acc, (bf16_t*)(ws + OFF_VP) + (size_t)tok0 * 256 + (ft - 28) * 64, 256);
  } else if (ft < 40) {
    head_norm_rope(acc, P.g_q_mem, ropeT, tok0, false, 0.18033688011112042f);
    store_rowmajor(acc, (bf16_t*)(ws + OFF_QM) + ((size_t)(b * 4 + (ft - 36)) * SEQ + s0) * 64, 64);
  } else if (ft == 44) {
    float* gt = (float*)(ws + OFF_GATES);
#pragma unroll
    for (int nt = 0; nt < 4; ++nt)
#pragma unroll
      for (int mt = 0; mt < 2; ++mt)
#pragma unroll
        for (int i = 0; i < 4; ++i) {
          const int f = 16 * mt + 4 * lg + i;
          if (f < 24) gt[(size_t)(tok0 + 16 * nt + l15) * 24 + f] = sigmoid_f(acc[mt][nt][i]);
        }
  }
}

DI void memkv_epilogue(const Params& P, f32x4 (&acc)[4][4], const int ft, const int tok0) {
  unsigned char* ws = P.ws;
  const int b = tok0 >> 8, m0 = tok0 & 255;
  if (ft < 4) {
    head_norm_rope(acc, P.g_k_mem, nullptr, 0, false, 1.f);
    store_rowmajor(acc, (bf16_t*)(ws + OFF_MK) + ((size_t)(b * 4 + ft) * MEML + m0) * 64, 64);
  } else {
    store_transposed(acc, (bf16_t*)(ws + OFF_MVT) + (size_t)(b * 4 + (ft - 4)) * 64 * MEML + m0, MEML);
  }
}

DI void p2_compress_item(const Params& P, int item) {
  unsigned char* ws = P.ws;
  const int which = item >> 6, bg = (item >> 2) & 15, ntile = item & 3;
  const int tid = otid(), lane = tid & 63, w = tid >> 6, l15 = lane & 15, lg = lane >> 4;
  const int n = ntile * 128 + w * 16 + l15;
  const int nc = n < 511 ? n : 510;
  const bf16_t* raw = (const bf16_t*)(ws + (which ? OFF_VCRAW : OFF_KCRAW)) + ((size_t)bg * SEQ + 16 * nc) * 64 + 8 * lg;
  const bf16_t* w1 = (const bf16_t*)(ws + (which ? OFF_WC1V : OFF_WC1K)) + (size_t)l15 * 2048 + 8 * lg;
  f32x4 acc[4];
#pragma unroll
  for (int i = 0; i < 4; ++i) acc[i] = (f32x4){0.f, 0.f, 0.f, 0.f};
#pragma unroll 4
  for (int ks = 0; ks < 64; ++ks) {
    const bf16x8 bq = ld16(raw + ks * 32);
#pragma unroll
    for (int mt = 0; mt < 4; ++mt) acc[mt] = mfma16(ld16(w1 + (size_t)mt * 16 * 2048 + ks * 32), bq, acc[mt]);
  }
  const float* bias = (const float*)(ws + OFF_BIASC) + which * 64;
#pragma unroll
  for (int mt = 0; mt < 4; ++mt)
#pragma unroll
    for (int i = 0; i < 4; ++i) acc[mt][i] = gelu_tanh(acc[mt][i] + bias[16 * mt + 4 * lg + i]);
  const bf16_t* w2 = (const bf16_t*)(ws + (which ? OFF_WC2V : OFF_WC2K)) + (size_t)l15 * 64 + 4 * lg;
  f32x4 a2[4];
#pragma unroll
  for (int i = 0; i < 4; ++i) a2[i] = (f32x4){0.f, 0.f, 0.f, 0.f};
#pragma unroll
  for (int ks2 = 0; ks2 < 2; ++ks2) {
    const bf16x8 hb = pack8(acc[2 * ks2], acc[2 * ks2 + 1]);
#pragma unroll
    for (int ft = 0; ft < 4; ++ft) {
      const bf16_t* wp = w2 + (size_t)ft * 16 * 64 + 32 * ks2;
      a2[ft] = mfma16(ld8x2(wp, wp + 16), hb, a2[ft]);
    }
  }
  const int b = bg >> 1;
  if (which == 0) {
    float ss = 0.f;
#pragma unroll
    for (int ft = 0; ft < 4; ++ft)
#pragma unroll
      for (int i = 0; i < 4; ++i) ss += a2[ft][i] * a2[ft][i];
    ss += shx(ss, 16); ss += shx(ss, 32);
    const float rinv = rsqrtf(ss * (1.f / 64.f) + 1e-6f);
#pragma unroll
    for (int ft = 0; ft < 4; ++ft) {
      const float4 g4 = *(const float4*)(P.g_k_cmp + 16 * ft + 4 * lg);
      a2[ft][0] *= rinv * g4.x; a2[ft][1] *= rinv * g4.y; a2[ft][2] *= rinv * g4.z; a2[ft][3] *= rinv * g4.w;
    }
    const float* rt = (const float*)(ws + OFF_ROPE) + ((size_t)b * SEQ + 16 * nc + 31) * 16 + 4 * (lg & 1);
    const float4 c4 = *(const float4*)rt, s4 = *(const float4*)(rt + 8);
    const float cs[4] = {c4.x, c4.y, c4.z, c4.w}, sn[4] = {s4.x, s4.y, s4.z, s4.w};
#pragma unroll
    for (int i = 0; i < 4; ++i) {
      const float own = a2[0][i];
      const float oth = shx(own, 32);
      a2[0][i] = (lg < 2) ? (own * cs[i] - oth * sn[i]) : (oth * sn[i] + own * cs[i]);
    }
    bf16_t* dst = (bf16_t*)(ws + OFF_KC) + ((size_t)bg * NCP + n) * 64 + 4 * lg;
    const float z = (n < 511) ? 1.f : 0.f;
#pragma unroll
    for (int ft = 0; ft < 4; ++ft) st4bf(dst + 16 * ft, a2[ft][0] * z, a2[ft][1] * z, a2[ft][2] * z, a2[ft][3] * z);
  } else {
    bf16_t* dst = (bf16_t*)(ws + OFF_VCT) + (size_t)bg * 64 * NCP + (n & ~31) + (((n & 15) >> 2) * 8 + ((n >> 4) & 1) * 4 + (n & 3));
    const float z = (n < 511) ? 1.f : 0.f;
#pragma unroll
    for (int ft = 0; ft < 4; ++ft)
#pragma unroll
      for (int i = 0; i < 4; ++i) dst[(size_t)(16 * ft + 4 * lg + i) * NCP] = f2bf(a2[ft][i] * z);
  }
}

enum { M_WIN = 0, M_SEL = 1, M_MEM = 2, M_CMPA = 3, M_CMPB = 4 };
constexpr int SM_IMP = 49152;
constexpr int SM_OACC = SM_IMP;
constexpr int SM_SEL = SM_OACC + 256 * 68 * 4;
constexpr int SM_MASK = SM_SEL + 1024;
constexpr int SM_LIST = SM_MASK + 1024;
constexpr int SM_LACC = SM_LIST + 8192;
constexpr int SM_QS = SM_LACC + 1024;
constexpr int SM_TOTAL = SM_QS + 32768;

template <int MODE>
DI void attn_run(const bf16_t* __restrict__ kbase, const bf16_t* __restrict__ vbase, const int vstride,
                 const int tile_begin, const int tile_end,
                 const bf16x8 (&qf)[2][2], const int (&tq)[2], const int (&tokl)[2],
                 f32x4 (&o)[2][4], float (&m)[2], float (&l)[2], unsigned char* smem, const int tmin, const float negM,
                 uint4& rk0, uint4& rv0, const bool pre  ,
                 const bf16_t* __restrict__ nk, const bf16_t* __restrict__ nv, const int nvs, const int nt  ,
                 const int ovr = -1  ) {
  if (tile_begin >= tile_end) return;
  const int tid = otid(), lane = tid & 63, l15 = lane & 15, lg = lane >> 4;
  const int srow = tid >> 3, sc = tid & 7;
  const unsigned short* selbits = (const unsigned short*)(smem + SM_SEL);
  float* imp = (float*)(smem + SM_IMP);
#define GL_(rk, rv, t) { rk = *(const uint4*)(kbase + ((size_t)((t) * 64 + srow)) * 64 + sc * 8); \
      if (MODE != M_CMPA) rv = *(const uint4*)(vbase + (size_t)srow * vstride + (t) * 64 + sc * 8); }
#define SW_(rk, rv, buf) { unsigned char* d_ = smem + (buf) * 9216 + srow * 128 + ((sc ^ (srow & 7)) << 4); *(uint4*)(d_) = rk; \
      if (MODE != M_CMPA) *(uint4*)(d_ + 18432) = rv; }
  f32x4 lacc[2] = {(f32x4){0.f, 0.f, 0.f, 0.f}, (f32x4){0.f, 0.f, 0.f, 0.f}};
  const bf16x8 ones = {(short)0x3F80, (short)0x3F80, (short)0x3F80, (short)0x3F80, (short)0x3F80, (short)0x3F80, (short)0x3F80, (short)0x3F80};
  auto compute = [&](const int t, const int buf) __attribute__((always_inline)) {
    const int xsw = ((lg ^ (l15 & 7)) << 4);
    const unsigned char* ck = smem + buf * 9216 + l15 * 128;
    const unsigned char* cv = smem + 18432 + buf * 9216 + l15 * 128;
    bool bit[2] = {true, true};
    bool need = true;
    if (MODE == M_SEL) {
#pragma unroll
      for (int c = 0; c < 2; ++c) bit[c] = (selbits[tokl[c] * 8 + (t >> 4)] >> (t & 15)) & 1;
      need = __any(bit[0] || bit[1]) != 0;
    }
    if (need) {
      f32x4 s[2][4];
#pragma unroll
      for (int c = 0; c < 2; ++c) {
        float ci = negM;
        if (MODE == M_SEL) ci = bit[c] ? negM : -__builtin_inff();
        const f32x4 cinit = {ci, ci, ci, ci};
#pragma unroll
        for (int kt = 0; kt < 4; ++kt) s[c][kt] = cinit;
      }
      {
        bf16x8 kf[2][4];
#pragma unroll
        for (int ks = 0; ks < 2; ++ks)
#pragma unroll
          for (int kt = 0; kt < 4; ++kt) kf[ks][kt] = ld16(ck + kt * 16 * 128 + (xsw ^ (ks << 6)));
        __builtin_amdgcn_sched_barrier(0);
#pragma unroll
        for (int ks = 0; ks < 2; ++ks)
#pragma unroll
          for (int kt = 0; kt < 4; ++kt) {
            s[0][kt] = mfma16(kf[ks][kt], qf[0][ks], s[0][kt]);
            s[1][kt] = mfma16(kf[ks][kt], qf[1][ks], s[1][kt]);
          }
      }
      bf16x8 vf[2][4];
      if (MODE != M_CMPA) {
#pragma unroll
        for (int ks2 = 0; ks2 < 2; ++ks2)
#pragma unroll
          for (int dt = 0; dt < 4; ++dt) vf[ks2][dt] = ld16(cv + dt * 16 * 128 + (xsw ^ (ks2 << 6)));
      }
      __builtin_amdgcn_sched_barrier(0);
      bool needmask = false;
      if (MODE == M_WIN) needmask = (t * 64 + 63 > tmin) || (t * 64 <= tmin + 7 - 512);
      if (MODE == M_SEL) needmask = (t * 64 + 63 > tmin);
      if (MODE == M_CMPA || MODE == M_CMPB) needmask = (16 * (t * 64 + 63) + 31 > tmin);
      if (needmask) {
        const int key0 = t * 64 + 4 * lg;
#pragma unroll
        for (int c = 0; c < 2; ++c)
#pragma unroll
          for (int kt = 0; kt < 4; ++kt)
#pragma unroll
            for (int i = 0; i < 4; ++i) {
              const int kk = key0 + 16 * kt + i;
              bool ok = true;
              if (MODE == M_WIN) ok = (kk <= tq[c]) && (kk > tq[c] - 512);
              if (MODE == M_SEL) ok = (kk <= tq[c]);
              if (MODE == M_CMPA || MODE == M_CMPB) ok = (16 * kk + 31 <= tq[c]);
              s[c][kt][i] = ok ? s[c][kt][i] : -__builtin_inff();
            }
      }
      bf16x8 pf[2][2];
#pragma unroll
      for (int c = 0; c < 2; ++c) {
#pragma unroll
        for (int kt = 0; kt < 4; ++kt) {
          float p0 = ex2(s[c][kt][0]), p1 = ex2(s[c][kt][1]), p2 = ex2(s[c][kt][2]), p3 = ex2(s[c][kt][3]);
          if (MODE == M_CMPB) { p0 *= l[c]; p1 *= l[c]; p2 *= l[c]; p3 *= l[c]; }
          s[c][kt][0] = p0; s[c][kt][1] = p1; s[c][kt][2] = p2; s[c][kt][3] = p3;
        }
        if (MODE == M_CMPB) {
          const int key0 = t * 64 + 4 * lg;
#pragma unroll
          for (int kt = 0; kt < 4; ++kt) {
            float pa = s[c][kt][0] + s[c][kt][1] + s[c][kt][2] + 0.5f * s[c][kt][3];
            float pb = 0.5f * s[c][kt][3];
            pa += dpp_x1f(pa); pa += dpp_x2f(pa);
            pb += dpp_x1f(pb); pb += dpp_x2f(pb);
            if ((lane & 3) == 0) {
              const int j = (key0 + 16 * kt) >> 2;
              float* ip = imp + tokl[c] * 129 + j;
              ip[0] += pa;
              __builtin_amdgcn_fence(__ATOMIC_RELEASE, "wavefront");
              if (j + 1 < 128) ip[1] += pb;
              __builtin_amdgcn_fence(__ATOMIC_RELEASE, "wavefront");
            }
          }
        }
        pf[c][0] = pack8(s[c][0], s[c][1]);
        pf[c][1] = pack8(s[c][2], s[c][3]);
        if (MODE != M_CMPB) {
          lacc[c] = mfma16(ones, pf[c][0], lacc[c]);
          lacc[c] = mfma16(ones, pf[c][1], lacc[c]);
        }
      }
      if (MODE != M_CMPA) {
#pragma unroll
        for (int ks2 = 0; ks2 < 2; ++ks2)
#pragma unroll
          for (int dt = 0; dt < 4; ++dt) {
            o[0][dt] = mfma16(vf[ks2][dt], pf[0][ks2], o[0][dt]);
            o[1][dt] = mfma16(vf[ks2][dt], pf[1][ks2], o[1][dt]);
          }
      }
    }
  };
  if (!pre) GL_(rk0, rv0, (ovr >= 0 ? ovr : tile_begin));
  SW_(rk0, rv0, 0);
  __syncthreads();
#pragma unroll 1
  for (int t = tile_begin; t < tile_end; ++t) {
    const int buf = (t - tile_begin) & 1;
    const bool more = (t + 1 < tile_end);
    if (more) GL_(rk0, rv0, t + 1)
    else if (nt >= 0) {
      rk0 = *(const uint4*)(nk + ((size_t)(nt * 64 + srow)) * 64 + sc * 8);
      rv0 = *(const uint4*)(nv + (size_t)srow * nvs + nt * 64 + sc * 8);
    }
    compute((t == tile_begin && ovr >= 0) ? ovr : t, buf);
    if (more) SW_(rk0, rv0, buf ^ 1);
    __syncthreads();
  }
#undef GL_
#undef SW_
  if (MODE != M_CMPB) { l[0] += lacc[0][0]; l[1] += lacc[1][0]; }
}

DI void attn_reset(f32x4 (&o)[2][4], float (&m)[2], float (&l)[2]) {
#pragma unroll
  for (int c = 0; c < 2; ++c) {
    m[c] = -__builtin_inff(); l[c] = 0.f;
#pragma unroll
    for (int dt = 0; dt < 4; ++dt) o[c][dt] = (f32x4){0.f, 0.f, 0.f, 0.f};
  }
}
DI void attn_accum(f32x4 (&ot)[2][4], const f32x4 (&o)[2][4], const float (&l)[2], const float (&gate)[2]) {
#pragma unroll
  for (int c = 0; c < 2; ++c) {
    const float f = gate[c] / fmaxf(l[c], 1.17549435e-38f);
#pragma unroll
    for (int dt = 0; dt < 4; ++dt) ot[c][dt] += o[c][dt] * f;
  }
}

DI void topk_select(unsigned char* smem, int cur) {
  const int tid = otid(), lane = tid & 63, tok = tid >> 3, sub = tid & 7;
  const float* imp = (const float*)(smem + SM_IMP);
  unsigned short* selbits = (unsigned short*)(smem + SM_SEL);
  unsigned bits = 0;
  if (cur <= 15) {
#pragma unroll
    for (int q = 0; q < 16; ++q) if (16 * sub + q <= cur) bits |= 1u << q;
  } else {
    unsigned key[16];
#pragma unroll
    for (int q = 0; q < 16; ++q) {
      const int j = 16 * sub + q;
      const bool cand = (j >= 1) && (j <= cur - 2);
      key[q] = cand ? (__float_as_uint(imp[tok * 129 + j]) + 1u) : 0u;
    }
    unsigned T = 0;
    bool done = false;
#pragma unroll 1
    for (int b = 30; b >= 0; --b) {
      const unsigned cnd = T | (1u << b);
      int cnt = 0;
#pragma unroll
      for (int q = 0; q < 16; ++q) cnt += (key[q] >= cnd) ? 1 : 0;
      cnt += dpp_x1(cnt); cnt += dpp_x2(cnt); cnt += dpp_hm(cnt);
      if (!done && cnt >= 13) T = cnd;
      done = done || (cnt == 13);
      if (__all(done)) break;
    }
    int cgt = 0, ceq = 0;
#pragma unroll
    for (int q = 0; q < 16; ++q) { cgt += (key[q] > T) ? 1 : 0; ceq += (key[q] == T) ? 1 : 0; }
    int gt_tot = cgt;
    gt_tot += dpp_x1(gt_tot); gt_tot += dpp_x2(gt_tot); gt_tot += dpp_hm(gt_tot);
    int pre = 0;
#pragma unroll
    for (int k = 0; k < 8; ++k) { const int v = __shfl(ceq, (lane & ~7) | k, 64); if (k < sub) pre += v; }
    const int quota = 13 - gt_tot;
#pragma unroll
    for (int q = 0; q < 16; ++q) {
      if (key[q] > T) bits |= 1u << q;
      else if (key[q] == T && T != 0u) { if (pre < quota) bits |= 1u << q; ++pre; }
    }
    if (sub == 0) bits |= 1u;
    if ((cur >> 4) == sub) bits |= 1u << (cur & 15);
    if (((cur - 1) >> 4) == sub) bits |= 1u << ((cur - 1) & 15);
  }
  selbits[tok * 8 + sub] = (unsigned short)bits;
}


DI void sel_sparse(const bf16_t* __restrict__ kbase, const bf16_t* __restrict__ vbase, const int jend  ,
                   unsigned char* smem, const float negM) {
  const int tid = otid(), lane = tid & 63, w = __builtin_amdgcn_readfirstlane(tid >> 6), l15 = lane & 15, lg = lane >> 4;
  const int srow = tid >> 3, sc = tid & 7;
  const unsigned* mask = (const unsigned*)(smem + SM_MASK);
  const unsigned char* list = smem + SM_LIST;
  float* oacc = (float*)(smem + SM_OACC);
  float* lacc_s = (float*)(smem + SM_LACC);
  const unsigned char* qs = smem + SM_QS;
  const bf16x8 ones = {(short)0x3F80, (short)0x3F80, (short)0x3F80, (short)0x3F80, (short)0x3F80, (short)0x3F80, (short)0x3F80, (short)0x3F80};
  uint4 rkA, rvA, rkB, rvB, rkC, rvC;
#define GLS_(rk, rv, t) { const int t_ = ((t) < jend) ? (t) : (jend - 1); rk = *(const uint4*)(kbase + ((size_t)(t_ * 64 + srow)) * 64 + sc * 8); rv = *(const uint4*)(vbase + (size_t)srow * SEQ + t_ * 64 + sc * 8); }
#define SWS_(rk, rv, u) { unsigned char* d_ = smem + (u) * 8192 + srow * 128 + ((sc ^ (srow & 7)) << 4); *(uint4*)(d_) = rk; *(uint4*)(d_ + 24576) = rv; }
  GLS_(rkA, rvA, 1); GLS_(rkB, rvB, 2); GLS_(rkC, rvC, 3);
  SWS_(rkA, rvA, 0); SWS_(rkB, rvB, 1); SWS_(rkC, rvC, 2);
  GLS_(rkA, rvA, 4); GLS_(rkB, rvB, 5); GLS_(rkC, rvC, 6);
  __syncthreads();
#pragma unroll 1
  for (int jb = 1; jb < jend; jb += 3) {
    const int n0 = __builtin_popcount(mask[2 * jb]) + __builtin_popcount(mask[2 * jb + 1]);
    const int n1 = (jb + 1 < jend) ? __builtin_popcount(mask[2 * jb + 2]) + __builtin_popcount(mask[2 * jb + 3]) : 0;
    const int n2 = (jb + 2 < jend) ? __builtin_popcount(mask[2 * jb + 4]) + __builtin_popcount(mask[2 * jb + 5]) : 0;
    const int c0 = (n0 + 3) >> 2, c1 = (n1 + 3) >> 2, c2 = (n2 + 3) >> 2;
    const int T = __builtin_amdgcn_readfirstlane(c0 + c1 + c2);
#pragma unroll 1
    for (int q0 = 0; q0 < T; q0 += 8) {
      const int q = q0 + w;
      const bool act = q < T;
      int u = 0, ct = q;
      if (ct >= c0) { ct -= c0; u = 1; if (ct >= c1) { ct -= c1; u = 2; } }
      f32x4 oo[4];
      float la0 = 0.f;
      int row = 0;
      bool valid = false;
#pragma unroll
      for (int dt = 0; dt < 4; ++dt) oo[dt] = (f32x4){0.f, 0.f, 0.f, 0.f};
      if (act) {
        const int j = jb + u;
        const int n = (u == 0) ? n0 : (u == 1) ? n1 : n2;
        const int xsw = ((lg ^ (l15 & 7)) << 4);
        const unsigned char* ck = smem + u * 8192 + l15 * 128;
        const unsigned char* cv = smem + 24576 + u * 8192 + l15 * 128;
        bf16x8 kf[2][4], vf[2][4];
#pragma unroll
        for (int ks = 0; ks < 2; ++ks)
#pragma unroll
          for (int kt = 0; kt < 4; ++kt) { kf[ks][kt] = ld16(ck + kt * 16 * 128 + (xsw ^ (ks << 6))); vf[ks][kt] = ld16(cv + kt * 16 * 128 + (xsw ^ (ks << 6))); }
        const int idx = 4 * ct + (l15 >> 2);
        valid = idx < n;
        const int tok = valid ? (int)list[j * 64 + idx] : 0;
        row = tok * 4 + (l15 & 3);
        const unsigned char* qr = qs + row * 128;
        const bf16x8 qa = ld16(qr + ((lg ^ (row & 7)) << 4)), qb = ld16(qr + (((4 + lg) ^ (row & 7)) << 4));
        const float ci = valid ? negM : -__builtin_inff();
        f32x4 sv[4];
#pragma unroll
        for (int kt = 0; kt < 4; ++kt) sv[kt] = (f32x4){ci, ci, ci, ci};
#pragma unroll
        for (int kt = 0; kt < 4; ++kt) { sv[kt] = mfma16(kf[0][kt], qa, sv[kt]); sv[kt] = mfma16(kf[1][kt], qb, sv[kt]); }
#pragma unroll
        for (int kt = 0; kt < 4; ++kt)
#pragma unroll
          for (int i = 0; i < 4; ++i) sv[kt][i] = ex2(sv[kt][i]);
        const bf16x8 pa = pack8(sv[0], sv[1]), pb = pack8(sv[2], sv[3]);
        f32x4 la = (f32x4){0.f, 0.f, 0.f, 0.f};
#pragma unroll
        for (int dt = 0; dt < 4; ++dt) { oo[dt] = mfma16(vf[0][dt], pa, oo[dt]); oo[dt] = mfma16(vf[1][dt], pb, oo[dt]); }
        la = mfma16(ones, pa, la); la = mfma16(ones, pb, la);
        la0 = la[0];
      }
      const bool lastr = (q0 + 8 >= T);
#pragma unroll
      for (int uu = 0; uu < 3; ++uu) {
        if (uu) __syncthreads();
        if (uu == 1 && lastr && jb + 3 < jend) {
          SWS_(rkA, rvA, 0); SWS_(rkB, rvB, 1); SWS_(rkC, rvC, 2);
          GLS_(rkA, rvA, jb + 6); GLS_(rkB, rvB, jb + 7); GLS_(rkC, rvC, jb + 8);
        }
        if (act && valid && u == uu) {
          float* op = oacc + row * 68 + 4 * lg;
          f32x4 cur4[4];
#pragma unroll
          for (int dt = 0; dt < 4; ++dt) cur4[dt] = *(const f32x4*)(op + 16 * dt);
#pragma unroll
          for (int dt = 0; dt < 4; ++dt) *(f32x4*)(op + 16 * dt) = cur4[dt] + oo[dt];
          if (lg == 0) lacc_s[row] += la0;
        }
      }
      if (!lastr) __syncthreads();
    }
    if (T == 0 && jb + 3 < jend) {
      SWS_(rkA, rvA, 0); SWS_(rkB, rvB, 1); SWS_(rkC, rvC, 2);
      GLS_(rkA, rvA, jb + 6); GLS_(rkB, rvB, jb + 7); GLS_(rkC, rvC, jb + 8);
    }
    __syncthreads();
  }
#undef GLS_
#undef SWS_
}

DI void p3_nsa_item(const Params& P, const int bg, const int qt, unsigned char* smem) {
  unsigned char* ws = P.ws;
  const int b = bg >> 1, gi = bg & 1, t0 = qt * 64, cur = qt;
  const int tid = otid(), lane = tid & 63, w = tid >> 6, l15 = lane & 15, lg = lane >> 4;
  int tokl[2], tq[2];
  bf16x8 qf[2][2];
  float gt[3][2];
  const int tmin = __builtin_amdgcn_readfirstlane(t0 + 8 * w);
  const float* shifts = (const float*)(ws + OFF_CNT + 128);
  const int head = 4 * gi + (l15 & 3);
#pragma unroll
  for (int c = 0; c < 2; ++c) {
    tokl[c] = 8 * w + 4 * c + (l15 >> 2);
    tq[c] = t0 + tokl[c];
    const bf16_t* qp = (const bf16_t*)(ws + OFF_QN) + ((size_t)(b * 8 + head) * SEQ + tq[c]) * 64 + 8 * lg;
    qf[c][0] = ld16(qp); qf[c][1] = ld16(qp + 32);
    const float* gp = (const float*)(ws + OFF_GATES) + (size_t)(b * SEQ + tq[c]) * 24 + head * 3;
    gt[0][c] = gp[0]; gt[1][c] = gp[1]; gt[2][c] = gp[2];
  }
  f32x4 ot[2][4], o[2][4];
  float m[2], l[2];
#pragma unroll
  for (int c = 0; c < 2; ++c)
#pragma unroll
    for (int dt = 0; dt < 4; ++dt) ot[c][dt] = (f32x4){0.f, 0.f, 0.f, 0.f};
  float* imp = (float*)(smem + SM_IMP);
  for (int i = tid; i < 64 * 129; i += 512) imp[i] = 0.f;
  const bf16_t* kc = (const bf16_t*)(ws + OFF_KC) + (size_t)bg * NCP * 64;
  const bf16_t* vct = (const bf16_t*)(ws + OFF_VCT) + (size_t)bg * 64 * NCP;
  const int ctiles = (qt >> 4) + 1;
#if EN_CMP
  attn_reset(o, m, l);
  uint4 pk_ = make_uint4(0, 0, 0, 0), pv_ = make_uint4(0, 0, 0, 0);
  attn_run<M_CMPA>(kc, vct, NCP, 0, ctiles, qf, tq, tokl, o, m, l, smem, tmin, shifts[2], pk_, pv_, false, kc, vct, NCP, 0);
#pragma unroll
  for (int c = 0; c < 2; ++c) l[c] = 1.f / fmaxf(l[c], 1.17549435e-38f);
  {
    const bf16_t* ksb_ = (const bf16_t*)(ws + OFF_KS) + (size_t)bg * SEQ * 64;
    const bf16_t* vsb_ = (const bf16_t*)(ws + OFF_VST) + (size_t)bg * 64 * SEQ;
    attn_run<M_CMPB>(kc, vct, NCP, 0, ctiles, qf, tq, tokl, o, m, l, smem, tmin, shifts[2], pk_, pv_, true, ksb_, vsb_, SEQ, (cur <= 29) ? 0 : -1);
  }
#pragma unroll
  for (int c = 0; c < 2; ++c)
#pragma unroll
    for (int dt = 0; dt < 4; ++dt) ot[c][dt] += o[c][dt] * gt[0][c];
#else
  __syncthreads();
#endif
  topk_select(smem, cur);
  __syncthreads();
#if EN_SEL
  {
    const bf16_t* kwb = (const bf16_t*)(ws + OFF_KW) + (size_t)bg * SEQ * 64;
    const bf16_t* vwb = (const bf16_t*)(ws + OFF_VWT) + (size_t)bg * 64 * SEQ;
    const int wt0 = (qt >= 8) ? (qt - 8) : 0;
    const bf16_t* ksb = (const bf16_t*)(ws + OFF_KS) + (size_t)bg * SEQ * 64;
    const bf16_t* vsb = (const bf16_t*)(ws + OFF_VST) + (size_t)bg * 64 * SEQ;
    if (cur <= 29) {
      attn_reset(o, m, l);
      attn_run<M_SEL>(ksb, vsb, SEQ, 0, cur + 1, qf, tq, tokl, o, m, l, smem, tmin, shifts[0], pk_, pv_, true, kwb, vwb, SEQ, wt0);
    } else {
      float* oacc = (float*)(smem + SM_OACC);
      for (int i = tid; i < 256 * 68; i += 512) oacc[i] = 0.f;
      if (tid < 256) { ((float*)(smem + SM_LACC))[tid] = 0.f; ((unsigned*)(smem + SM_MASK))[tid] = 0u; }
#pragma unroll
      for (int c = 0; c < 2; ++c) {
        const int row = tokl[c] * 4 + (l15 & 3);
        unsigned char* qr = smem + SM_QS + row * 128;
        *(bf16x8*)(qr + ((lg ^ (row & 7)) << 4)) = qf[c][0];
        *(bf16x8*)(qr + (((4 + lg) ^ (row & 7)) << 4)) = qf[c][1];
      }
      __syncthreads();
      {
        const int tok = tid >> 3, sub = tid & 7;
        unsigned bits = ((const unsigned short*)(smem + SM_SEL))[tok * 8 + sub];
        unsigned* mk = (unsigned*)(smem + SM_MASK);
        while (bits) {
          const int q = __builtin_ctz(bits); bits &= bits - 1;
          const int j = 16 * sub + q;
          if (j != 0 && j < cur - 1) atomicOr(&mk[2 * j + (tok >> 5)], 1u << (tok & 31));
        }
      }
      __syncthreads();
      if (tid >= 1 && tid < cur - 1) {
        const unsigned* mk = (const unsigned*)(smem + SM_MASK);
        unsigned char* ls = smem + SM_LIST + tid * 64;
        unsigned m0 = mk[2 * tid], m1 = mk[2 * tid + 1];
        int k = 0;
        while (m0) { ls[k++] = (unsigned char)__builtin_ctz(m0); m0 &= m0 - 1; }
        while (m1) { ls[k++] = (unsigned char)(32 + __builtin_ctz(m1)); m1 &= m1 - 1; }
      }
      __syncthreads();
      sel_sparse(ksb, vsb, cur - 1, smem, shifts[0]);
      attn_reset(o, m, l);
      attn_run<M_SEL>(ksb, vsb, SEQ, cur - 2, cur + 1, qf, tq, tokl, o, m, l, smem, tmin, shifts[0], pk_, pv_, false, kwb, vwb, SEQ, wt0, 0);
#pragma unroll
      for (int c = 0; c < 2; ++c) {
        const int row = tokl[c] * 4 + (l15 & 3);
        const float* op = (const float*)(smem + SM_OACC) + row * 68 + 4 * lg;
#pragma unroll
        for (int dt = 0; dt < 4; ++dt)
#pragma unroll
          for (int i = 0; i < 4; ++i) o[c][dt][i] += op[16 * dt + i];
        l[c] += ((const float*)(smem + SM_LACC))[row];
      }
    }
  }
  attn_accum(ot, o, l, gt[1]);
#endif
#if EN_WIN
  attn_reset(o, m, l);
  attn_run<M_WIN>((const bf16_t*)(ws + OFF_KW) + (size_t)bg * SEQ * 64, (const bf16_t*)(ws + OFF_VWT) + (size_t)bg * 64 * SEQ, SEQ,
                  (qt >= 8) ? (qt - 8) : 0, cur + 1, qf, tq, tokl, o, m, l, smem, tmin, shifts[1], pk_, pv_, (EN_SEL != 0), nullptr, nullptr, 0, -1);
  attn_accum(ot, o, l, gt[2]);
#endif
#pragma unroll
  for (int c = 0; c < 2; ++c) {
    const size_t off = (size_t)(b * SEQ + tq[c]) * 1024 + head * 64 + 4 * lg;
    const bf16_t* zp = (const bf16_t*)(ws + OFF_ZS) + off;
    bf16_t* yp = (bf16_t*)(ws + OFF_Y) + off;
#pragma unroll
    for (int dt = 0; dt < 4; ++dt) {
      const uint2 zz = *(const uint2*)(zp + 16 * dt);
      st4bf(yp + 16 * dt, ot[c][dt][0] * bf2f((bf16_t)(zz.x & 0xffff)), ot[c][dt][1] * bf2f((bf16_t)(zz.x >> 16)),
            ot[c][dt][2] * bf2f((bf16_t)(zz.y & 0xffff)), ot[c][dt][3] * bf2f((bf16_t)(zz.y >> 16)));
    }
  }
}

DI void p3_mem_item(const Params& P, const int bh, const int qt, unsigned char* smem) {
  unsigned char* ws = P.ws;
  const int b = bh >> 2, h = bh & 3, t0 = qt * 256;
  const int tid = otid(), lane = tid & 63, w = tid >> 6, l15 = lane & 15, lg = lane >> 4;
  int tokl[2], tq[2];
  bf16x8 qf[2][2];
  const int tmin = 0;
#pragma unroll
  for (int c = 0; c < 2; ++c) {
    tokl[c] = 0;
    tq[c] = t0 + 32 * w + 16 * c + l15;
    const bf16_t* qp = (const bf16_t*)(ws + OFF_QM) + ((size_t)bh * SEQ + tq[c]) * 64 + 8 * lg;
    qf[c][0] = ld16(qp); qf[c][1] = ld16(qp + 32);
  }
  f32x4 o[2][4];
  float m[2], l[2];
  uint4 pk_ = make_uint4(0, 0, 0, 0), pv_ = make_uint4(0, 0, 0, 0);
  attn_reset(o, m, l);
  attn_run<M_MEM>((const bf16_t*)(ws + OFF_MK) + (size_t)bh * MEML * 64, (const bf16_t*)(ws + OFF_MVT) + (size_t)bh * 64 * MEML, MEML,
                  0, 4, qf, tq, tokl, o, m, l, smem, tmin, ((const float*)(ws + OFF_CNT + 128))[3], pk_, pv_, false, nullptr, nullptr, 0, -1);
#pragma unroll
  for (int c = 0; c < 2; ++c) {
    const float f = 1.f / fmaxf(l[c], 1.17549435e-38f);
    const size_t off = (size_t)(b * SEQ + tq[c]) * 1024 + 768 + h * 64 + 4 * lg;
    const bf16_t* zp = (const bf16_t*)(ws + OFF_ZS) + off;
    bf16_t* yp = (bf16_t*)(ws + OFF_Y) + off;
#pragma unroll
    for (int dt = 0; dt < 4; ++dt) {
      const uint2 zz = *(const uint2*)(zp + 16 * dt);
      st4bf(yp + 16 * dt, o[c][dt][0] * f * bf2f((bf16_t)(zz.x & 0xffff)), o[c][dt][1] * f * bf2f((bf16_t)(zz.x >> 16)),
            o[c][dt][2] * f * bf2f((bf16_t)(zz.y & 0xffff)), o[c][dt][3] * f * bf2f((bf16_t)(zz.y >> 16)));
    }
  }
}

DI void p3_pool_item(const Params& P, int item, unsigned char* smem) {
  unsigned char* ws = P.ws;
  const int tok0 = item * 128, s0 = tok0 & (SEQ - 1);
  const int tid = otid(), lane = tid & 63, w = tid >> 6, l15 = lane & 15, lg = lane >> 4;
  const bf16_t* vp = (const bf16_t*)(ws + OFF_VP);
  for (int q = tid; q < 143 * 32; q += 512) {
    const int r = q >> 5, cch = q & 31;
    const int s = s0 - 15 + r;
    uint4 v = make_uint4(0, 0, 0, 0);
    if (s >= 0) v = *(const uint4*)(vp + (size_t)(tok0 - 15 + r) * 256 + cch * 8);
    *(uint4*)(smem + r * 528 + cch * 16) = v;
  }
  __syncthreads();
  const int rown = 15 + 16 * w + l15;
  const int s = s0 + 16 * w + l15;
  const int tok = tok0 + 16 * w + l15;
#pragma unroll
  for (int gp = 0; gp < 4; ++gp) {
    const int win = 2 << gp;
    const float rc = 1.f / (float)((s + 1 < win) ? (s + 1) : win);
    f32x4 acc[4];
#pragma unroll
    for (int i = 0; i < 4; ++i) acc[i] = (f32x4){0.f, 0.f, 0.f, 0.f};
#pragma unroll
    for (int ks = 0; ks < 2; ++ks) {
      const int cb = (gp * 64 + 32 * ks + 8 * lg) * 2;
      float sum[8];
#pragma unroll
      for (int j = 0; j < 8; ++j) sum[j] = 0.f;
      uint4 own = make_uint4(0, 0, 0, 0);
      for (int i = 0; i < win; ++i) {
        const uint4 v = *(const uint4*)(smem + (rown - i) * 528 + cb);
        if (i == 0) own = v;
        sum[0] += bf2f((bf16_t)(v.x & 0xffff)); sum[1] += bf2f((bf16_t)(v.x >> 16));
        sum[2] += bf2f((bf16_t)(v.y & 0xffff)); sum[3] += bf2f((bf16_t)(v.y >> 16));
        sum[4] += bf2f((bf16_t)(v.z & 0xffff)); sum[5] += bf2f((bf16_t)(v.z >> 16));
        sum[6] += bf2f((bf16_t)(v.w & 0xffff)); sum[7] += bf2f((bf16_t)(v.w >> 16));
      }
      uint4 pk;
      pk.x = pack2(sum[0] * rc - bf2f((bf16_t)(own.x & 0xffff)), sum[1] * rc - bf2f((bf16_t)(own.x >> 16)));
      pk.y = pack2(sum[2] * rc - bf2f((bf16_t)(own.y & 0xffff)), sum[3] * rc - bf2f((bf16_t)(own.y >> 16)));
      pk.z = pack2(sum[4] * rc - bf2f((bf16_t)(own.z & 0xffff)), sum[5] * rc - bf2f((bf16_t)(own.z >> 16)));
      pk.w = pack2(sum[6] * rc - bf2f((bf16_t)(own.w & 0xffff)), sum[7] * rc - bf2f((bf16_t)(own.w >> 16)));
      const bf16x8 bq = __builtin_bit_cast(bf16x8, pk);
      const bf16_t* wp = (const bf16_t*)(ws + OFF_WPOOL) + (size_t)gp * 4096 + (size_t)l15 * 64 + 32 * ks + 8 * lg;
#pragma unroll
      for (int mt = 0; mt < 4; ++mt) acc[mt] = mfma16(ld16(wp + mt * 16 * 64), bq, acc[mt]);
    }
    const size_t off = (size_t)tok * 1024 + 512 + gp * 64 + 4 * lg;
    const bf16_t* zp = (const bf16_t*)(ws + OFF_ZS) + off;
    bf16_t* yp = (bf16_t*)(ws + OFF_Y) + off;
#pragma unroll
    for (int mt = 0; mt < 4; ++mt) {
      const float4 ps = *(const float4*)(P.pool_scale + gp * 64 + 16 * mt + 4 * lg);
      const uint2 zz = *(const uint2*)(zp + 16 * mt);
      st4bf(yp + 16 * mt, acc[mt][0] * ps.x * bf2f((bf16_t)(zz.x & 0xffff)), acc[mt][1] * ps.y * bf2f((bf16_t)(zz.x >> 16)),
            acc[mt][2] * ps.z * bf2f((bf16_t)(zz.y & 0xffff)), acc[mt][3] * ps.w * bf2f((bf16_t)(zz.y >> 16)));
    }
  }
  __syncthreads();
}

struct EpiIn {
  static constexpr bool PERM = false, AFTER_DRAIN = false;
  const Params* P;
  __device__ __forceinline__ void operator()(const f32x4 (&acc)[2][2][4][2], const pg8::Unit& u, int wr, int wc, int fr, int fq) const {
    const int ft = u.pn * 4 + wc;
#pragma unroll
    for (int ai = 0; ai < 2; ++ai) {
      f32x4 t[4][4];
#pragma unroll
      for (int mt = 0; mt < 4; ++mt)
#pragma unroll
        for (int m = 0; m < 4; ++m) t[mt][m] = acc[ai][mt >> 1][m][mt & 1];
      inproj_epilogue(*P, t, ft, u.pm * 256 + ai * 128 + wr * 64);
    }
  }
};
struct EpiMemKV {
  static constexpr bool PERM = false, AFTER_DRAIN = false;
  const Params* P;
  __device__ __forceinline__ void operator()(const f32x4 (&acc)[2][2][4][2], const pg8::Unit& u, int wr, int wc, int fr, int fq) const {
    const int ft = u.pn * 4 + wc;
#pragma unroll
    for (int ai = 0; ai < 2; ++ai) {
      f32x4 t[4][4];
#pragma unroll
      for (int mt = 0; mt < 4; ++mt)
#pragma unroll
        for (int m = 0; m < 4; ++m) t[mt][m] = acc[ai][mt >> 1][m][mt & 1];
      memkv_epilogue(*P, t, ft, u.pm * 256 + ai * 128 + wr * 64);
    }
  }
};
struct EpiOut {
  static constexpr bool PERM = false, AFTER_DRAIN = false;
  const float* x; float* out;
  __device__ __forceinline__ void operator()(const f32x4 (&acc)[2][2][4][2], const pg8::Unit& u, int wr, int wc, int fr, int fq) const {
    const int ln = otid() & 63;
    const int row0 = u.pm * 256 + wr * 64 + (ln & 15), col0 = u.pn * 256 + wc * 32 + 4 * (ln >> 4);
#pragma unroll
    for (int ai = 0; ai < 2; ++ai) {
      float4 xv[4][2][2];
#pragma unroll
      for (int m = 0; m < 4; ++m)
#pragma unroll
        for (int bj = 0; bj < 2; ++bj)
#pragma unroll
          for (int n = 0; n < 2; ++n)
            xv[m][bj][n] = ntload4(x + (size_t)(row0 + ai * 128 + m * 16) * DM + col0 + bj * 128 + n * 16);
#pragma unroll
      for (int m = 0; m < 4; ++m)
#pragma unroll
        for (int bj = 0; bj < 2; ++bj)
#pragma unroll
          for (int n = 0; n < 2; ++n) {
            const size_t off = (size_t)(row0 + ai * 128 + m * 16) * DM + col0 + bj * 128 + n * 16;
            float4 r; r.x = xv[m][bj][n].x + acc[ai][bj][m][n][0]; r.y = xv[m][bj][n].y + acc[ai][bj][m][n][1];
            r.z = xv[m][bj][n].z + acc[ai][bj][m][n][2]; r.w = xv[m][bj][n].w + acc[ai][bj][m][n][3];
            ntstore4(out + off, r);
          }
    }
  }
};

__device__ unsigned g_bar[2];
typedef __attribute__((address_space(4))) const Params* KargPtr;
DI const Params& PP(const Params&) { KargPtr p = (KargPtr)__builtin_amdgcn_kernarg_segment_ptr(); asm volatile("" : "+s"(p)); return *(const Params*)p; }
DI void grid_barrier(unsigned* cnt, const unsigned target) {
  asm volatile("s_waitcnt vmcnt(0)" ::: "memory");
  __syncthreads();
  if (threadIdx.x == 0) {
    __builtin_amdgcn_fence(__ATOMIC_RELEASE, "agent");
    __hip_atomic_fetch_add(cnt, 1u, __ATOMIC_RELAXED, __HIP_MEMORY_SCOPE_AGENT);
    while (__hip_atomic_load(cnt, __ATOMIC_RELAXED, __HIP_MEMORY_SCOPE_AGENT) < target) __builtin_amdgcn_s_sleep(2);
    __builtin_amdgcn_fence(__ATOMIC_ACQUIRE, "agent");
  }
  __syncthreads();
}

__global__ void __launch_bounds__(512, 2) fwd_megakernel(Params P) {
  cg::grid_group grid = cg::this_grid();
  __shared__ __attribute__((aligned(16))) unsigned char smem[SM_TOTAL];
  __shared__ int s_item;
  const int tid = threadIdx.x;
  const int nblk = gridDim.x;
  int* counter = (int*)(P.ws + OFF_CNT);
  unsigned* gbar = &g_bar[0];
  if (P.out == nullptr) grid.sync();
  const unsigned nb = gridDim.x;

  if (blockIdx.x == 0 && tid < 16) counter[tid] = 0;
  if (blockIdx.x == 0 && tid >= 64 && tid < 68) {
    const int wch = tid - 64;
    const float* gq = (wch == 3) ? P.g_q_mem : P.g_q_nsa;
    const float* gk = (wch == 0) ? P.g_k_slc : (wch == 1) ? P.g_k_win : (wch == 2) ? P.g_k_cmp : P.g_k_mem;
    float mq = 0.f, mk = 0.f;
    for (int i = 0; i < 64; ++i) { mq = fmaxf(mq, fabsf(gq[i])); mk = fmaxf(mk, fabsf(gk[i])); }
    const float bound = 11.8f * mq * mk;
    ((float*)(P.ws + OFF_CNT + 128))[wch] = -fmaxf(0.f, bound - 64.f);
  }
  {
    constexpr int NTR = P0_NT / 2, NBI = 64, NROWIT = (NTOK + NMEMTOK) / 64;
    for (int it = blockIdx.x; it < NTR + NBI + NROWIT; it += nblk) {
      if (it < NTR) p0_transpose_pair(PP(P), it, smem);
      else if (it < NTR + NBI) p0_bias_pair(PP(P), it - NTR, smem);
      else { p0_row_norm2(PP(P), (it - NTR - NBI) * 64 + (tid >> 6) * 8); }
    }
  }
  grid_barrier(gbar, nb);
  {
    pg8::Gemm g; g.A = (const bf16_t*)(P.ws + OFF_XB); g.Bt = (const bf16_t*)(P.ws + OFF_WTIN); g.M = NTOK; g.N = NFP; g.K = DM;
    pg8::StaticOrder S; S.init(g.M, g.N, nblk, (int)blockIdx.x);
    EpiIn E; E.P = &PP(P);
    pg8::gemm_phase<EpiIn, pg8::StaticOrder, false>((PG8_LAS unsigned char*)smem, g, S, E, nullptr);
  }
  grid_barrier(gbar, 2 * nb);
  if (blockIdx.x < 128 || nblk < 144) {
    for (int it = blockIdx.x; it < 128; it += nblk) p2_compress_item(PP(P), it);
  }
  if (blockIdx.x >= 128 || nblk < 144) {
    pg8::Gemm g2; g2.A = (const bf16_t*)(P.ws + OFF_MH); g2.Bt = (const bf16_t*)(P.ws + OFF_WTMKV); g2.M = NMEMTOK; g2.N = 512; g2.K = DM;
    pg8::StaticOrder S2; S2.init(g2.M, g2.N, nblk, (int)((blockIdx.x + nblk - 128) % nblk));
    EpiMemKV E2; E2.P = &PP(P);
    __syncthreads();
    pg8::gemm_phase<EpiMemKV, pg8::StaticOrder, false>((PG8_LAS unsigned char*)smem, g2, S2, E2, nullptr);
  }
  grid_barrier(gbar, 3 * nb);
  {
    constexpr int NX_NSA = 256, NX_MEM = 128, NX_POOL = 64;
    for (int qi = 0; qi < 8; ++qi) {
      const int xq = (blockIdx.x + qi) & 7;
      for (;;) {
        __syncthreads();
        if (tid == 0) s_item = atomicAdd(counter + xq, 1);
        __syncthreads();
        const int it = s_item;
        if (it >= NX_NSA + NX_MEM + NX_POOL) break;
        if (it < NX_NSA) {
          p3_nsa_item(PP(P), 2 * xq + (it >> 7), 127 - (it & 127), smem);
        } else if (it < NX_NSA + NX_MEM) {
          const int i2 = it - NX_NSA;
          p3_mem_item(PP(P), 4 * xq + (i2 >> 5), i2 & 31, smem);
        } else {
          p3_pool_item(PP(P), xq * NX_POOL + (it - NX_NSA - NX_MEM), smem);
        }
      }
    }
  }
  grid_barrier(gbar, 4 * nb);
  {
    pg8::Gemm g; g.A = (const bf16_t*)(P.ws + OFF_Y); g.Bt = (const bf16_t*)(P.ws + OFF_WTOUT); g.M = NTOK; g.N = DM; g.K = DM;
    pg8::StaticOrder S; S.init(g.M, g.N, nblk, (int)blockIdx.x);
    const Params& P4 = PP(P);
    EpiOut E; E.x = P4.x; E.out = P4.out;
    pg8::gemm_phase<EpiOut, pg8::StaticOrder, false>((PG8_LAS unsigned char*)smem, g, S, E, nullptr);
  }
  if (tid == 0) {
    const unsigned old = __hip_atomic_fetch_add(&g_bar[1], 1u, __ATOMIC_RELAXED, __HIP_MEMORY_SCOPE_AGENT);
    if (old == nb - 1) { __hip_atomic_store(&g_bar[0], 0u, __ATOMIC_RELAXED, __HIP_MEMORY_SCOPE_AGENT); __hip_atomic_store(&g_bar[1], 0u, __ATOMIC_RELAXED, __HIP_MEMORY_SCOPE_AGENT); }
  }
}

extern "C" void kernel_launch(void* const* d_in, const int* in_sizes, int n_in,
                              void* d_out, int out_size, void* d_ws, size_t ws_size,
                              hipStream_t stream) {
  static int grid_blocks = 0;
  if (!grid_blocks) {
    int dev = 0, cus = 0, per_cu = 0;
    (void)hipGetDevice(&dev);
    (void)hipDeviceGetAttribute(&cus, hipDeviceAttributeMultiprocessorCount, dev);
    (void)hipOccupancyMaxActiveBlocksPerMultiprocessor(&per_cu, fwd_megakernel, 512, 0);
    if (per_cu > 1) per_cu = 1;
    if (per_cu < 1) per_cu = 1;
    grid_blocks = cus * per_cu;
  }
  if (ws_size < WS_NEED) { fprintf(stderr, "workspace too small: %zu < %zu\n", ws_size, (size_t)WS_NEED); return; }
  Params p{};
  p.x = (const float*)d_in[0]; p.mem = (const float*)d_in[1]; p.pos = (const int*)d_in[2];
  p.g_norm = (const float*)d_in[3]; p.w_in = (const float*)d_in[4]; p.g_q_nsa = (const float*)d_in[5];
  p.g_k_cmp = (const float*)d_in[6]; p.g_k_slc = (const float*)d_in[7]; p.g_k_win = (const float*)d_in[8];
  p.cmp_pos_k = (const float*)d_in[9]; p.w_cmp_k1 = (const float*)d_in[10]; p.w_cmp_k2 = (const float*)d_in[11];
  p.cmp_pos_v = (const float*)d_in[12]; p.w_cmp_v1 = (const float*)d_in[13]; p.w_cmp_v2 = (const float*)d_in[14];
  p.w_pool = (const float*)d_in[15]; p.pool_scale = (const float*)d_in[16]; p.g_mem = (const float*)d_in[17];
  p.w_mem_kv = (const float*)d_in[18]; p.g_q_mem = (const float*)d_in[19]; p.g_k_mem = (const float*)d_in[20];
  p.w_out = (const float*)d_in[21];
  p.out = (float*)d_out;
  p.ws = (unsigned char*)d_ws;
  void* args[] = {&p};
  hipError_t e = hipLaunchCooperativeKernel((void*)fwd_megakernel, dim3(grid_blocks), dim3(512), args, 0, stream);
  if (e != hipSuccess) fprintf(stderr, "cooperative launch failed: %s (grid %d)\n", hipGetErrorString(e), grid_blocks);
}
```

```cpp
#include <hip/hip_runtime.h>
#include <hip/hip_cooperative_groups.h>
#include <cstdio>
namespace cg = cooperative_groups;

#define DI __device__ __forceinline__
typedef unsigned short bf16_t;
typedef short bf16x8 __attribute__((ext_vector_type(8)));
typedef short s16x4 __attribute__((ext_vector_type(4)));
typedef float f32x4 __attribute__((ext_vector_type(4)));

#ifndef EN_POOL
#define EN_POOL 1
#endif
#ifndef EN_MEM
#define EN_MEM 1
#endif
#ifndef EN_NSA
#define EN_NSA 1
#endif
#ifndef EN_CMP
#define EN_CMP 1
#endif
#ifndef EN_SEL
#define EN_SEL 1
#endif
#ifndef EN_WIN
#define EN_WIN 1
#endif

constexpr int SEQ = 8192;
constexpr int NB = 8;
constexpr int NTOK = NB * SEQ;
constexpr int DM = 1024;
constexpr int INW = 2840;
constexpr int NFP = 3072;
constexpr int MEML = 256;
constexpr int NMEMTOK = NB * MEML;
constexpr int NCP = 512;

constexpr size_t al256(size_t x) { return (x + 255) & ~(size_t)255; }
constexpr size_t OFF_XB    = 0;
constexpr size_t OFF_WTIN  = OFF_XB    + al256((size_t)NTOK * DM * 2);
constexpr size_t OFF_WTOUT = OFF_WTIN  + al256((size_t)NFP * DM * 2);
constexpr size_t OFF_MH    = OFF_WTOUT + al256((size_t)DM * DM * 2);
constexpr size_t OFF_WTMKV = OFF_MH    + al256((size_t)NMEMTOK * DM * 2);
constexpr size_t OFF_WC1K  = OFF_WTMKV + al256((size_t)512 * DM * 2);
constexpr size_t OFF_WC1V  = OFF_WC1K  + al256((size_t)64 * 2048 * 2);
constexpr size_t OFF_WC2K  = OFF_WC1V  + al256((size_t)64 * 2048 * 2);
constexpr size_t OFF_WC2V  = OFF_WC2K  + al256((size_t)64 * 64 * 2);
constexpr size_t OFF_WPOOL = OFF_WC2V  + al256((size_t)64 * 64 * 2);
constexpr size_t OFF_BIASC = OFF_WPOOL + al256((size_t)4 * 64 * 64 * 2);
constexpr size_t OFF_ROPE  = OFF_BIASC + al256((size_t)128 * 4);
constexpr size_t OFF_QN    = OFF_ROPE  + al256((size_t)NTOK * 16 * 4);
constexpr size_t OFF_KCRAW = OFF_QN    + al256((size_t)NTOK * 512 * 2);
constexpr size_t OFF_VCRAW = OFF_KCRAW + al256((size_t)NTOK * 128 * 2);
constexpr size_t OFF_KS    = OFF_VCRAW + al256((size_t)NTOK * 128 * 2);
constexpr size_t OFF_VST   = OFF_KS    + al256((size_t)NTOK * 128 * 2);
constexpr size_t OFF_KW    = OFF_VST   + al256((size_t)NTOK * 128 * 2);
constexpr size_t OFF_VWT   = OFF_KW    + al256((size_t)NTOK * 128 * 2);
constexpr size_t OFF_ZS    = OFF_VWT   + al256((size_t)NTOK * 128 * 2);
constexpr size_t OFF_VP    = OFF_ZS    + al256((size_t)NTOK * 1024 * 2);
constexpr size_t OFF_QM    = OFF_VP    + al256((size_t)NTOK * 256 * 2);
constexpr size_t OFF_GATES = OFF_QM    + al256((size_t)NTOK * 256 * 2);
constexpr size_t OFF_KC    = OFF_GATES + al256((size_t)NTOK * 24 * 4);
constexpr size_t OFF_VCT   = OFF_KC    + al256((size_t)16 * NCP * 64 * 2);
constexpr size_t OFF_MK    = OFF_VCT   + al256((size_t)16 * 64 * NCP * 2);
constexpr size_t OFF_MVT   = OFF_MK    + al256((size_t)32 * MEML * 64 * 2);
constexpr size_t OFF_Y     = OFF_MVT   + al256((size_t)32 * 64 * MEML * 2);
constexpr size_t OFF_CNT   = OFF_Y     + al256((size_t)NTOK * 1024 * 2);
constexpr size_t WS_NEED   = OFF_CNT   + 512;

struct Params {
  const float* x; const float* mem; const int* pos;
  const float* g_norm; const float* w_in; const float* g_q_nsa; const float* g_k_cmp; const float* g_k_slc; const float* g_k_win;
  const float* cmp_pos_k; const float* w_cmp_k1; const float* w_cmp_k2; const float* cmp_pos_v; const float* w_cmp_v1; const float* w_cmp_v2;
  const float* w_pool; const float* pool_scale; const float* g_mem; const float* w_mem_kv; const float* g_q_mem; const float* g_k_mem; const float* w_out;
  float* out;
  unsigned char* ws;
};

DI float4 ntload4(const float* p) { f32x4 v = __builtin_nontemporal_load((const f32x4*)p); return make_float4(v[0], v[1], v[2], v[3]); }
DI void ntstore4(float* p, float4 r) { f32x4 v = {r.x, r.y, r.z, r.w}; __builtin_nontemporal_store(v, (f32x4*)p); }
DI int otid() { int t = threadIdx.x; asm volatile("" : "+v"(t)); return t; }
DI bf16_t f2bf(float f) { unsigned u = __float_as_uint(f); u += 0x7fffu + ((u >> 16) & 1u); return (bf16_t)(u >> 16); }
DI float bf2f(bf16_t h) { return __uint_as_float(((unsigned)h) << 16); }
typedef __bf16 hwbf2 __attribute__((ext_vector_type(2)));
typedef float f32x2 __attribute__((ext_vector_type(2)));
DI unsigned pack2(float a, float b) { f32x2 v = {a, b}; hwbf2 r = __builtin_convertvector(v, hwbf2); return __builtin_bit_cast(unsigned, r); }
DI float ex2(float x) { return __builtin_amdgcn_exp2f(x); }
DI f32x4 mfma16(bf16x8 a, bf16x8 b, f32x4 c) { return __builtin_amdgcn_mfma_f32_16x16x32_bf16(a, b, c, 0, 0, 0); }
DI float shx(float v, int m) { return __shfl_xor(v, m, 64); }
#define DPP_I(v, ctrl) __builtin_amdgcn_update_dpp(0, (v), (ctrl), 0xF, 0xF, false)
DI int   dpp_x1(int v)   { return DPP_I(v, 0xB1); }
DI int   dpp_x2(int v)   { return DPP_I(v, 0x4E); }
DI int   dpp_hm(int v)   { return DPP_I(v, 0x141); }
DI float dpp_x1f(float v) { return __builtin_bit_cast(float, dpp_x1(__builtin_bit_cast(int, v))); }
DI float dpp_x2f(float v) { return __builtin_bit_cast(float, dpp_x2(__builtin_bit_cast(int, v))); }
DI float silu_f(float z) { return z * __builtin_amdgcn_rcpf(1.f + __builtin_amdgcn_exp2f(-1.4426950408889634f * z)); }
DI float sigmoid_f(float z) { return __builtin_amdgcn_rcpf(1.f + __builtin_amdgcn_exp2f(-1.4426950408889634f * z)); }
DI float gelu_tanh(float x) {
  float u = 0.7978845608028654f * (x + 0.044715f * x * x * x);
  float t = 1.f - 2.f * __builtin_amdgcn_rcpf(__builtin_amdgcn_exp2f(2.8853900817779268f * u) + 1.f);
  return 0.5f * x * (1.f + t);
}
DI bf16x8 pack8(f32x4 a, f32x4 b) {
  uint4 p; p.x = pack2(a[0], a[1]); p.y = pack2(a[2], a[3]); p.z = pack2(b[0], b[1]); p.w = pack2(b[2], b[3]);
  return __builtin_bit_cast(bf16x8, p);
}
DI bf16x8 ld16(const void* p) { return *(const bf16x8*)p; }
DI bf16x8 ld8x2(const void* p0, const void* p1) {
  uint2 a = *(const uint2*)p0; uint2 b = *(const uint2*)p1;
  uint4 r; r.x = a.x; r.y = a.y; r.z = b.x; r.w = b.y;
  return __builtin_bit_cast(bf16x8, r);
}
DI void st4bf(bf16_t* dst, float a, float b, float c, float d) {
  uint2 v; v.x = pack2(a, b); v.y = pack2(c, d); *(uint2*)dst = v;
}

DI void p0_row_norm(const Params& P, int row) {
  const int lane = otid() & 63;
  const bool is_x = row < NTOK;
  const float* src = is_x ? (P.x + (size_t)row * DM) : (P.mem + (size_t)(row - NTOK) * DM);
  bf16_t* dst = is_x ? ((bf16_t*)(P.ws + OFF_XB) + (size_t)row * DM) : ((bf16_t*)(P.ws + OFF_MH) + (size_t)(row - NTOK) * DM);
  float4 v[4];
  float ss = 0.f;
#pragma unroll
  for (int u = 0; u < 4; ++u) {
    v[u] = *(const float4*)(src + lane * 4 + 256 * u);
    ss += v[u].x * v[u].x + v[u].y * v[u].y + v[u].z * v[u].z + v[u].w * v[u].w;
  }
#pragma unroll
  for (int m = 32; m >= 1; m >>= 1) ss += shx(ss, m);
  const float rinv = rsqrtf(ss * (1.f / 1024.f) + 1e-6f);
#pragma unroll
  for (int u = 0; u < 4; ++u) st4bf(dst + lane * 4 + 256 * u, v[u].x * rinv, v[u].y * rinv, v[u].z * rinv, v[u].w * rinv);
  if (is_x && lane < 8) {
    float invf = 1.0f;
    if (lane == 1) invf = 0.19392274f; else if (lane == 2) invf = 0.03760603f; else if (lane == 3) invf = 0.0072926646f;
    else if (lane == 4) invf = 0.0014142136f; else if (lane == 5) invf = 0.0002742482f; else if (lane == 6) invf = 5.3182957e-05f;
    else if (lane == 7) invf = 1.0313385e-05f;
    const float ang = (float)P.pos[row] * invf;
    const double a = (double)ang;
    const double k = rint(a * 0.15915494309189535);
    const float r = (float)(a - k * 6.283185307179586);
    float* rt = (float*)(P.ws + OFF_ROPE) + (size_t)row * 16;
    rt[lane] = cosf(r);
    rt[8 + lane] = sinf(r);
  }
}

DI void p0_row_norm2(const Params& P, int row) {
  const int lane = otid() & 63;
  const bool is_x = row < NTOK;
  const float* src = is_x ? (P.x + (size_t)row * DM) : (P.mem + (size_t)(row - NTOK) * DM);
  bf16_t* dst = is_x ? ((bf16_t*)(P.ws + OFF_XB) + (size_t)row * DM) : ((bf16_t*)(P.ws + OFF_MH) + (size_t)(row - NTOK) * DM);
  float4 v[8][4];
#pragma unroll
  for (int r = 0; r < 8; ++r)
#pragma unroll
    for (int u = 0; u < 4; ++u) v[r][u] = ntload4(src + r * DM + lane * 4 + 256 * u);
#pragma unroll
  for (int r = 0; r < 8; ++r) {
    float ss = 0.f;
#pragma unroll
    for (int u = 0; u < 4; ++u) ss += v[r][u].x * v[r][u].x + v[r][u].y * v[r][u].y + v[r][u].z * v[r][u].z + v[r][u].w * v[r][u].w;
#pragma unroll
    for (int m = 32; m >= 1; m >>= 1) ss += shx(ss, m);
    const float rinv = rsqrtf(ss * (1.f / 1024.f) + 1e-6f);
#pragma unroll
    for (int u = 0; u < 4; ++u) st4bf(dst + r * DM + lane * 4 + 256 * u, v[r][u].x * rinv, v[r][u].y * rinv, v[r][u].z * rinv, v[r][u].w * rinv);
  }
  if (is_x) {
    const int fi = lane & 7, rr = row + (lane >> 3);
    float invf = 1.0f;
    if (fi == 1) invf = 0.19392274f; else if (fi == 2) invf = 0.03760603f; else if (fi == 3) invf = 0.0072926646f;
    else if (fi == 4) invf = 0.0014142136f; else if (fi == 5) invf = 0.0002742482f; else if (fi == 6) invf = 5.3182957e-05f;
    else if (fi == 7) invf = 1.0313385e-05f;
    const float ang = (float)P.pos[rr] * invf;
    const double a = (double)ang;
    const double k = rint(a * 0.15915494309189535);
    const float r = (float)(a - k * 6.283185307179586);
    float* rt = (float*)(P.ws + OFF_ROPE) + (size_t)rr * 16;
    rt[fi] = cosf(r);
    rt[8 + fi] = sinf(r);
  }
}

struct TrJob { const float* src; int src_ld, k0, fsrc0, nvalid; bf16_t* dst; int dst_ld, fdst0; const float* scale; int split; };
DI void p0_transpose_tile(const TrJob& j, bool valid, int tid, unsigned char* smem) {
  float* tile = (float*)smem;
  const int r = tid >> 4, c4 = (tid & 15) * 4;
  if (valid) {
#pragma unroll
    for (int ps = 0; ps < 4; ++ps) {
      const int k = r + 16 * ps;
      float4 v = make_float4(0.f, 0.f, 0.f, 0.f);
      if (c4 < j.nvalid) v = *(const float4*)(j.src + (size_t)(j.k0 + k) * j.src_ld + j.fsrc0 + c4);
      const float sc = j.scale ? j.scale[j.k0 + k] : 1.f;
      tile[(c4 + 0) * 65 + k] = v.x * sc; tile[(c4 + 1) * 65 + k] = v.y * sc;
      tile[(c4 + 2) * 65 + k] = v.z * sc; tile[(c4 + 3) * 65 + k] = v.w * sc;
    }
  }
  __syncthreads();
  if (valid) {
    const int f = tid >> 2, kc = (tid & 3) * 16;
    const int row = j.split ? (j.fdst0 + (f & 31) + 128 * (f >> 5)) : (j.fdst0 + f);
    bf16_t* d = j.dst + (size_t)row * j.dst_ld + j.k0 + kc;
#pragma unroll
    for (int q = 0; q < 4; ++q) st4bf(d + 4 * q, tile[f * 65 + kc + 4 * q], tile[f * 65 + kc + 4 * q + 1], tile[f * 65 + kc + 4 * q + 2], tile[f * 65 + kc + 4 * q + 3]);
  }
  __syncthreads();
}
constexpr int P0_NT = 768 + 256 + 128 + 32 + 32 + 2 + 4;

DI TrJob p0_job(const Params& P, int t) {
  unsigned char* ws = P.ws;
  TrJob j{};
  j.src_ld = 64; j.nvalid = 64; j.dst_ld = 64;
  if (t < 768) {
    const int ft = t % 48, kt = t / 48;
    j.src = P.w_in; j.src_ld = INW; j.k0 = kt * 64; j.scale = P.g_norm; j.dst = (bf16_t*)(ws + OFF_WTIN); j.dst_ld = DM; j.split = 1;
    j.fdst0 = (ft >> 2) * 256 + (ft & 3) * 32;
    if (ft < 20) j.fsrc0 = ft * 64; else if (ft < 44) j.fsrc0 = 1304 + (ft - 20) * 64; else { j.fsrc0 = 1280; j.nvalid = (ft == 44) ? 24 : 0; }
    return j;
  }
  t -= 768;
  if (t < 256) { j.src = P.w_out; j.src_ld = DM; j.k0 = (t >> 4) * 64; j.fsrc0 = (t & 15) * 64; j.dst = (bf16_t*)(ws + OFF_WTOUT); j.dst_ld = DM; j.fdst0 = (t & 15) * 64; return j; }
  t -= 256;
  if (t < 128) { const int ft = t & 7; j.src = P.w_mem_kv; j.src_ld = 512; j.k0 = (t >> 3) * 64; j.fsrc0 = ft * 64; j.scale = P.g_mem; j.dst = (bf16_t*)(ws + OFF_WTMKV); j.dst_ld = DM;
                 j.split = 1; j.fdst0 = (ft >> 2) * 256 + (ft & 3) * 32; return j; }
  t -= 128;
  if (t < 32) { j.src = P.w_cmp_k1; j.k0 = t * 64; j.dst = (bf16_t*)(ws + OFF_WC1K); j.dst_ld = 2048; return j; }
  t -= 32;
  if (t < 32) { j.src = P.w_cmp_v1; j.k0 = t * 64; j.dst = (bf16_t*)(ws + OFF_WC1V); j.dst_ld = 2048; return j; }
  t -= 32;
  if (t == 0) { j.src = P.w_cmp_k2; j.dst = (bf16_t*)(ws + OFF_WC2K); return j; }
  if (t == 1) { j.src = P.w_cmp_v2; j.dst = (bf16_t*)(ws + OFF_WC2V); return j; }
  t -= 2;
  j.src = P.w_pool + (size_t)t * 4096; j.dst = (bf16_t*)(ws + OFF_WPOOL) + (size_t)t * 4096;
  return j;
}
DI void p0_transpose_pair(const Params& P, int it, unsigned char* smem) {
  const int tid = otid(), half = tid >> 8;
  const int t = 2 * it + half;
  const bool valid = t < P0_NT;
  const TrJob j = p0_job(P, valid ? t : 0);
  p0_transpose_tile(j, valid, tid & 255, smem + half * 17408);
}

DI void p0_bias_pair(const Params& P, int it2, unsigned char* smem) {
  const int tid0 = otid(), half = tid0 >> 8, tid = tid0 & 255, it = 2 * it2 + half;
  const int which = it >> 6, e = it & 63;
  const float* pe = which ? P.cmp_pos_v : P.cmp_pos_k;
  const float* w1 = which ? P.w_cmp_v1 : P.w_cmp_k1;
  float s = 0.f;
  for (int k = tid; k < 2048; k += 256) s += pe[k] * w1[(size_t)k * 64 + e];
#pragma unroll
  for (int m = 32; m >= 1; m >>= 1) s += shx(s, m);
  float* red = (float*)smem + half * 8;
  __syncthreads();
  if ((tid & 63) == 0) red[tid >> 6] = s;
  __syncthreads();
  if (tid == 0) ((float*)(P.ws + OFF_BIASC))[it] = red[0] + red[1] + red[2] + red[3];
  __syncthreads();
}

namespace pg8 {
#define PG8_LAS __attribute__((address_space(3)))
typedef unsigned short bf16_t;
typedef short bf16x8 __attribute__((ext_vector_type(8)));
typedef float f32x4 __attribute__((ext_vector_type(4)));
typedef unsigned u32x4 __attribute__((ext_vector_type(4)));
constexpr int BM = 256, BK = 64, HALF = 128, HTB = HALF * BK * 2  , STAGE_BYTES = 8 * HTB, NXCD = 8, WGM = 8;

__host__ __device__ __forceinline__ int lds_byte(int r, int c) { const int st = (r >> 4) * 2 + (c >> 5), rr = r & 15, cc = c & 31, ob = rr * 64 + cc * 2; return st * 1024 + (ob ^ (((ob >> 9) & 1) << 5)); }
__host__ __device__ __forceinline__ void stage_rc(int b, int& R, int& C) { const int st = b / 1024, sb = b % 1024, swz = sb ^ (((sb >> 9) & 1) << 5); R = (st >> 1) * 16 + swz / 64; C = (st & 1) * 32 + (swz % 64) / 2; }
__host__ __device__ __forceinline__ int perm32(int rho) { const int n = rho >> 4, i = rho & 15; return 8 * (i >> 2) + 4 * n + (i & 3); }

struct Unit { int pm, pn; };
struct Gemm { const bf16_t* A; const bf16_t* Bt; int M, N, K; };

struct StaticOrder {
    int nM, nN, nwg, G, c;
    __host__ __device__ void init(int M, int N, int G_, int c_) { nM = M / BM; nN = N / BM; nwg = nM * nN; G = G_; c = c_; }
    __host__ __device__ bool next(int i, Unit& u) const {
        const long L = (long)i * G + c; if (L >= nwg) return false;
        int wgid = (int)L; { const int q = nwg / NXCD, r = nwg % NXCD, xcd = wgid % NXCD, off = wgid / NXCD; wgid = (xcd < r ? xcd * (q + 1) : r * (q + 1) + (xcd - r) * q) + off; }
        const int nig = WGM * nN, gid = wgid / nig, fm = gid * WGM, gsz = (nM - fm) < WGM ? (nM - fm) : WGM;
        u.pm = fm + ((wgid % nig) % gsz); u.pn = (wgid % nig) / gsz; return true;
    }
    __device__ __forceinline__ void a_ready(const Unit&) const {}
    __device__ __forceinline__ void done(const Unit&) const {}
};
template <class Epi, class Sched, bool STAMP = false>
__device__ __forceinline__ void gemm_phase(PG8_LAS unsigned char* lds, const Gemm g, const Sched& S, const Epi& E, unsigned long long* stamps) {
    const int tid = otid(), wid = __builtin_amdgcn_readfirstlane(tid >> 6), lane = tid & 63, wr = wid >> 2, wc = wid & 3, fr = lane & 15, fq = lane >> 4;
    const int K = g.K, nt = K / BK;
    int ts_lo = 0, ts_hi = 0, nts = 0; const unsigned long long rt_entry = STAMP ? (unsigned long long)wall_clock64() : 0ull;
#define PG8_STAMP() do { if (STAMP && wid == 0 && nts < 64) { const unsigned long long _c = (unsigned long long)clock64(); \
        ts_lo = (lane == nts) ? (int)(unsigned)_c : ts_lo; ts_hi = (lane == nts) ? (int)(unsigned)(_c >> 32) : ts_hi; ++nts; } } while (0)
    PG8_STAMP();
    unsigned voffA[2], voffB[2];
#pragma unroll
    for (int i = 0; i < 2; ++i) { int R, C; stage_rc(tid * 16 + i * 8192, R, C); const int Rb = Epi::PERM ? ((R & ~31) + perm32(R & 31)) : R;
        voffA[i] = (unsigned)(R * K + C) * 2u; voffB[i] = (unsigned)(Rb * K + C) * 2u; }
    const size_t kstep = (size_t)(BK * 2);
    const size_t hstep = (size_t)HALF * K * 2;
    const size_t tstep = 2 * hstep;
    const unsigned ldsw = (unsigned)wid * 1024u;
    const int aoff = lds_byte(wr * 64 + fr, fq * 8), boff = lds_byte(wc * 32 + fr, fq * 8);
#define PG8_SA(b, h) (((b) * 2 + (h)) * HTB)
#define PG8_SB(b, h) ((4 + (b) * 2 + (h)) * HTB)
#define PG8_STAGE(bufoff, gbase, voff) do { _Pragma("unroll") for (int _i = 0; _i < 2; ++_i) \
        __builtin_amdgcn_global_load_lds((const unsigned*)((const char*)(gbase) + (voff)[_i]), (PG8_LAS unsigned*)(lds + (bufoff) + ldsw + _i * 8192), 16, 0, 0); } while (0)
#define PG8_LDA(dst, b, h) do { _Pragma("unroll") for (int m = 0; m < 4; ++m) _Pragma("unroll") for (int k = 0; k < 2; ++k) dst[m][k] = *(const PG8_LAS bf16x8*)(lds + PG8_SA(b, h) + aoff + m * 2048 + k * 1024); } while (0)
#define PG8_LDB(dst, b, h) do { _Pragma("unroll") for (int n = 0; n < 2; ++n) _Pragma("unroll") for (int k = 0; k < 2; ++k) dst[n][k] = *(const PG8_LAS bf16x8*)(lds + PG8_SB(b, h) + boff + n * 2048 + k * 1024); } while (0)
#define PG8_MMA(ai, bj, At, Bt) do { __builtin_amdgcn_s_setprio(1); _Pragma("unroll") for (int m = 0; m < 4; ++m) _Pragma("unroll") for (int n = 0; n < 2; ++n) _Pragma("unroll") for (int k = 0; k < 2; ++k) \
        acc[ai][bj][m][n] = __builtin_amdgcn_mfma_f32_16x16x32_bf16(Bt[n][k], At[m][k], acc[ai][bj][m][n], 0, 0, 0); __builtin_amdgcn_s_setprio(0); } while (0)
#define PG8_WAIT_V(n) asm volatile("s_waitcnt vmcnt(" #n ")" ::: "memory")
#define PG8_WAIT_L(n) asm volatile("s_waitcnt lgkmcnt(" #n ")" ::: "memory")
#define PG8_BAR __builtin_amdgcn_s_barrier()
#define PG8_SCHED __builtin_amdgcn_sched_barrier(0)
    Unit cur, nxt; int ui = 0;
    if (!S.next(0, cur)) return;
    f32x4 acc[2][2][4][2];
#pragma unroll
    for (int a = 0; a < 2; ++a)
#pragma unroll
        for (int b = 0; b < 2; ++b)
#pragma unroll
            for (int m = 0; m < 4; ++m)
#pragma unroll
                for (int n = 0; n < 2; ++n) acc[a][b][m][n] = (f32x4){0.f, 0.f, 0.f, 0.f};
    bf16x8 At[4][2], B0[2][2], B1[2][2];
    const char* cA = (const char*)g.A + (size_t)cur.pm * tstep; const char* cB = (const char*)g.Bt + (size_t)cur.pn * tstep;
    S.a_ready(cur);
    PG8_STAGE(PG8_SB(0, 0), cB, voffB); PG8_STAGE(PG8_SA(0, 0), cA, voffA); PG8_STAGE(PG8_SB(0, 1), cB + hstep, voffB); PG8_STAGE(PG8_SA(0, 1), cA + hstep, voffA);
    if (wr == 1) PG8_BAR;
    PG8_WAIT_V(4); PG8_BAR;
    PG8_STAGE(PG8_SB(1, 0), cB + kstep, voffB); PG8_STAGE(PG8_SA(1, 0), cA + kstep, voffA); PG8_STAGE(PG8_SB(1, 1), cB + hstep + kstep, voffB);
    PG8_WAIT_V(6); PG8_BAR;
    PG8_STAMP();
    for (;;) {
        const bool has_next = S.next(ui + 1, nxt);
        const char* nA = has_next ? (const char*)g.A + (size_t)nxt.pm * tstep : cA; const char* nB = has_next ? (const char*)g.Bt + (size_t)nxt.pn * tstep : cB;
        for (int t = 0; t < nt; t += 2) {
            const bool last = (t == nt - 2);
            const char* a1 = cA + (size_t)(t + 1) * kstep;
            const char* a2 = last ? nA : cA + (size_t)(t + 2) * kstep; const char* b2 = last ? nB : cB + (size_t)(t + 2) * kstep;
            const char* a3 = a2 + kstep; const char* b3 = b2 + kstep;
            if (last && has_next) S.a_ready(nxt);
            PG8_LDB(B0, 0, 0); PG8_SCHED; PG8_LDA(At, 0, 0); PG8_STAGE(PG8_SA(1, 1), a1 + hstep, voffA);
            PG8_WAIT_L(8); PG8_BAR; PG8_WAIT_L(0); PG8_MMA(0, 0, At, B0); PG8_BAR; PG8_SCHED;
            PG8_LDB(B1, 0, 1); PG8_STAGE(PG8_SB(0, 0), b2, voffB);
            PG8_BAR; PG8_WAIT_L(0); PG8_MMA(0, 1, At, B1); PG8_BAR;
            PG8_LDA(At, 0, 1); PG8_STAGE(PG8_SA(0, 0), a2, voffA);
            PG8_BAR; PG8_WAIT_L(0); PG8_MMA(1, 0, At, B0); PG8_BAR; PG8_SCHED;
            PG8_STAGE(PG8_SB(0, 1), b2 + hstep, voffB);
            PG8_WAIT_V(6); PG8_BAR; PG8_MMA(1, 1, At, B1); PG8_BAR;
            PG8_LDB(B0, 1, 0); PG8_SCHED; PG8_LDA(At, 1, 0); PG8_STAGE(PG8_SA(0, 1), a2 + hstep, voffA);
            PG8_WAIT_L(8); PG8_BAR; PG8_WAIT_L(0); PG8_MMA(0, 0, At, B0); PG8_BAR; PG8_SCHED;
            PG8_LDB(B1, 1, 1); PG8_STAGE(PG8_SB(1, 0), b3, voffB);
            PG8_BAR; PG8_WAIT_L(0); PG8_MMA(0, 1, At, B1); PG8_BAR;
            PG8_LDA(At, 1, 1); PG8_STAGE(PG8_SA(1, 0), a3, voffA);
            PG8_BAR; PG8_WAIT_L(0); PG8_MMA(1, 0, At, B0); PG8_BAR; PG8_SCHED;
            PG8_STAGE(PG8_SB(1, 1), b3 + hstep, voffB);
            PG8_WAIT_V(6); PG8_BAR; PG8_MMA(1, 1, At, B1); PG8_BAR;
        }
        PG8_STAMP();
        if constexpr (!Epi::AFTER_DRAIN) { E(acc, cur, wr, wc, fr, fq); S.done(cur); }
        PG8_STAMP();
        if (!has_next) break;
#pragma unroll
        for (int a = 0; a < 2; ++a)
#pragma unroll
            for (int b = 0; b < 2; ++b)
#pragma unroll
                for (int m = 0; m < 4; ++m)
#pragma unroll
                    for (int n = 0; n < 2; ++n) acc[a][b][m][n] = (f32x4){0.f, 0.f, 0.f, 0.f};
        cur = nxt; cA = nA; cB = nB; ++ui;
    }
    PG8_WAIT_V(0);
    if (wr == 0) PG8_BAR;
    PG8_BAR;
    if constexpr (Epi::AFTER_DRAIN) { E.fused(acc, cur, wr, wc, fr, fq, lds, wid, lane); S.done(cur); }
    PG8_STAMP();
    if (STAMP && wid == 0) { stamps[lane] = lane < nts ? (((unsigned long long)(unsigned)ts_hi << 32) | (unsigned)ts_lo) : 0ull;
        if (lane == 62) stamps[62] = rt_entry; if (lane == 63) stamps[63] = (unsigned long long)wall_clock64(); }
#undef PG8_STAMP
#undef PG8_SA
#undef PG8_SB
#undef PG8_STAGE
#undef PG8_LDA
#undef PG8_LDB
#undef PG8_MMA
#undef PG8_WAIT_V
#undef PG8_WAIT_L
#undef PG8_BAR
#undef PG8_SCHED
}
}

DI void head_norm_rope(f32x4 (&acc)[4][4], const float* gain, const float* ropeT, int tok0, bool rope, float outscale) {
  const int lane = otid() & 63, l15 = lane & 15, lg = lane >> 4;
  float gn[4][4];
#pragma unroll
  for (int mt = 0; mt < 4; ++mt) { float4 g4 = *(const float4*)(gain + 16 * mt + 4 * lg); gn[mt][0] = g4.x; gn[mt][1] = g4.y; gn[mt][2] = g4.z; gn[mt][3] = g4.w; }
#pragma unroll
  for (int nt = 0; nt < 4; ++nt) {
    float ss = 0.f;
#pragma unroll
    for (int mt = 0; mt < 4; ++mt)
#pragma unroll
      for (int i = 0; i < 4; ++i) ss += acc[mt][nt][i] * acc[mt][nt][i];
    ss += shx(ss, 16); ss += shx(ss, 32);
    const float rinv = rsqrtf(ss * (1.f / 64.f) + 1e-6f);
#pragma unroll
    for (int mt = 0; mt < 4; ++mt)
#pragma unroll
      for (int i = 0; i < 4; ++i) acc[mt][nt][i] = acc[mt][nt][i] * rinv * gn[mt][i];
    if (rope) {
      const float* rt = ropeT + (size_t)(tok0 + 16 * nt + l15) * 16 + 4 * (lg & 1);
      const float4 c4 = *(const float4*)rt, s4 = *(const float4*)(rt + 8);
      const float cs[4] = {c4.x, c4.y, c4.z, c4.w}, sn[4] = {s4.x, s4.y, s4.z, s4.w};
#pragma unroll
      for (int i = 0; i < 4; ++i) {
        const float own = acc[0][nt][i];
        const float oth = shx(own, 32);
        acc[0][nt][i] = (lg < 2) ? (own * cs[i] - oth * sn[i]) : (oth * sn[i] + own * cs[i]);
      }
    }
#pragma unroll
    for (int mt = 0; mt < 4; ++mt)
#pragma unroll
      for (int i = 0; i < 4; ++i) acc[mt][nt][i] *= outscale;
  }
}

DI void store_rowmajor(const f32x4 (&acc)[4][4], bf16_t* dst, size_t ld) {
  const int lane = otid() & 63, l15 = lane & 15, lg = lane >> 4, odd = lg & 1;
#pragma unroll
  for (int p = 0; p < 2; ++p) {
    bf16_t* rowp = dst + (size_t)(16 * (2 * p + odd) + l15) * ld + 4 * (lg - odd);
#pragma unroll
    for (int mt = 0; mt < 4; ++mt) {
      unsigned ax = pack2(acc[mt][2 * p][0], acc[mt][2 * p][1]), ay = pack2(acc[mt][2 * p][2], acc[mt][2 * p][3]);
      unsigned bx = pack2(acc[mt][2 * p + 1][0], acc[mt][2 * p + 1][1]), by = pack2(acc[mt][2 * p + 1][2], acc[mt][2 * p + 1][3]);
      const auto r0 = __builtin_amdgcn_permlane16_swap(ax, bx, false, false);
      const auto r1 = __builtin_amdgcn_permlane16_swap(ay, by, false, false);
      uint4 v; v.x = r0[0]; v.y = r1[0]; v.z = r0[1]; v.w = r1[1];
      *(uint4*)(rowp + 16 * mt) = v;
    }
  }
}
DI void store_transposed(const f32x4 (&acc)[4][4], bf16_t* dst, size_t ld) {
  const int lane = otid() & 63, l15 = lane & 15, lg = lane >> 4;
#pragma unroll
  for (int nt = 0; nt < 4; ++nt)
#pragma unroll
    for (int mt = 0; mt < 4; ++mt)
#pragma unroll
      for (int i = 0; i < 4; ++i) dst[(size_t)(16 * mt + 4 * lg + i) * ld + 32 * (nt >> 1) + (l15 >> 2) * 8 + (nt & 1) * 4 + (l15 & 3)] = f2bf(acc[mt][nt][i]);
}

DI void inproj_epilogue(const Params& P, f32x4 (&acc)[4][4], const int ft, const int tok0) {
  unsigned char* ws = P.ws;
  const int lane = otid() & 63, l15 = lane & 15, lg = lane >> 4;
  const int b = tok0 >> 13, s0 = tok0 & (SEQ - 1);
  const float* ropeT = (const float*)(ws + OFF_ROPE);
  if (ft < 8) {
    head_norm_rope(acc, P.g_q_nsa, ropeT, tok0, true, 0.18033688011112042f);
    store_rowmajor(acc, (bf16_t*)(ws + OFF_QN) + ((size_t)(b * 8 + ft) * SEQ + s0) * 64, 64);
  } else if (ft < 20) {
    const int idx = (ft - 8) >> 1, gi = (ft - 8) & 1;
    const size_t rm = ((size_t)(b * 2 + gi) * SEQ + s0) * 64;
    const size_t tr = (size_t)(b * 2 + gi) * 64 * SEQ + s0;
    if (idx == 0) store_rowmajor(acc, (bf16_t*)(ws + OFF_KCRAW) + rm, 64);
    else if (idx == 1) store_rowmajor(acc, (bf16_t*)(ws + OFF_VCRAW) + rm, 64);
    else if (idx == 2) { head_norm_rope(acc, P.g_k_slc, ropeT, tok0, true, 1.f); store_rowmajor(acc, (bf16_t*)(ws + OFF_KS) + rm, 64); }
    else if (idx == 3) store_transposed(acc, (bf16_t*)(ws + OFF_VST) + tr, SEQ);
    else if (idx == 4) { head_norm_rope(acc, P.g_k_win, ropeT, tok0, true, 1.f); store_rowmajor(acc, (bf16_t*)(ws + OFF_KW) + rm, 64); }
    else store_transposed(acc, (bf16_t*)(ws + OFF_VWT) + tr, SEQ);
  } else if (ft < 28 || (ft >= 32 && ft < 36) || (ft >= 40 && ft < 44)) {
    const int zoff = (ft < 28) ? (ft - 20) * 64 : (ft < 36 ? 512 + (ft - 32) * 64 : 768 + (ft - 40) * 64);
#pragma unroll
    for (int mt = 0; mt < 4; ++mt)
#pragma unroll
      for (int nt = 0; nt < 4; ++nt)
#pragma unroll
        for (int i = 0; i < 4; ++i) acc[mt][nt][i] = silu_f(acc[mt][nt][i]);
    store_rowmajor(acc, (bf16_t*)(ws + OFF_ZS) + (size_t)tok0 * 1024 + zoff, 1024);
  } else if (ft < 32) {
    store_rowmajor(acc, (bf16_t*)(ws + OFF_VP) + (size_t)tok0 * 256 + (ft - 28) * 64, 256);
  } else if (ft < 40) {
    head_norm_rope(acc, P.g_q_mem, ropeT, tok0, false, 0.18033688011112042f);
    store_rowmajor(acc, (bf16_t*)(ws + OFF_QM) + ((size_t)(b * 4 + (ft - 36)) * SEQ + s0) * 64, 64);
  } else if (ft == 44) {
    float* gt = (float*)(ws + OFF_GATES);
#pragma unroll
    for (int nt = 0; nt < 4; ++nt)
#pragma unroll
      for (int mt = 0; mt < 2; ++mt)
#pragma unroll
        for (int i = 0; i < 4; ++i) {
          const int f = 16 * mt + 4 * lg + i;
          if (f < 24) gt[(size_t)(tok0 + 16 * nt + l15) * 24 + f] = sigmoid_f(acc[mt][nt][i]);
        }
  }
}

DI void memkv_epilogue(const Params& P, f32x4 (&acc)[4][4], const int ft, const int tok0) {
  unsigned char* ws = P.ws;
  const int b = tok0 >> 8, m0 = tok0 & 255;
  if (ft < 4) {
    head_norm_rope(acc, P.g_k_mem, nullptr, 0, false, 1.f);
    store_rowmajor(acc, (bf16_t*)(ws + OFF_MK) + ((size_t)(b * 4 + ft) * MEML + m0) * 64, 64);
  } else {
    store_transposed(acc, (bf16_t*)(ws + OFF_MVT) + (size_t)(b * 4 + (ft - 4)) * 64 * MEML + m0, MEML);
  }
}

DI void p2_compress_item(const Params& P, int item) {
  unsigned char* ws = P.ws;
  const int which = item >> 6, bg = (item >> 2) & 15, ntile = item & 3;
  const int tid = otid(), lane = tid & 63, w = tid >> 6, l15 = lane & 15, lg = lane >> 4;
  const int n = ntile * 128 + w * 16 + l15;
  const int nc = n < 511 ? n : 510;
  const bf16_t* raw = (const bf16_t*)(ws + (which ? OFF_VCRAW : OFF_KCRAW)) + ((size_t)bg * SEQ + 16 * nc) * 64 + 8 * lg;
  const bf16_t* w1 = (const bf16_t*)(ws + (which ? OFF_WC1V : OFF_WC1K)) + (size_t)l15 * 2048 + 8 * lg;
  f32x4 acc[4];
#pragma unroll
  for (int i = 0; i < 4; ++i) acc[i] = (f32x4){0.f, 0.f, 0.f, 0.f};
#pragma unroll 4
  for (int ks = 0; ks < 64; ++ks) {
    const bf16x8 bq = ld16(raw + ks * 32);
#pragma unroll
    for (int mt = 0; mt < 4; ++mt) acc[mt] = mfma16(ld16(w1 + (size_t)mt * 16 * 2048 + ks * 32), bq, acc[mt]);
  }
  const float* bias = (const float*)(ws + OFF_BIASC) + which * 64;
#pragma unroll
  for (int mt = 0; mt < 4; ++mt)
#pragma unroll
    for (int i = 0; i < 4; ++i) acc[mt][i] = gelu_tanh(acc[mt][i] + bias[16 * mt + 4 * lg + i]);
  const bf16_t* w2 = (const bf16_t*)(ws + (which ? OFF_WC2V : OFF_WC2K)) + (size_t)l15 * 64 + 4 * lg;
  f32x4 a2[4];
#pragma unroll
  for (int i = 0; i < 4; ++i) a2[i] = (f32x4){0.f, 0.f, 0.f, 0.f};
#pragma unroll
  for (int ks2 = 0; ks2 < 2; ++ks2) {
    const bf16x8 hb = pack8(acc[2 * ks2], acc[2 * ks2 + 1]);
#pragma unroll
    for (int ft = 0; ft < 4; ++ft) {
      const bf16_t* wp = w2 + (size_t)ft * 16 * 64 + 32 * ks2;
      a2[ft] = mfma16(ld8x2(wp, wp + 16), hb, a2[ft]);
    }
  }
  const int b = bg >> 1;
  if (which == 0) {
    float ss = 0.f;
#pragma unroll
    for (int ft = 0; ft < 4; ++ft)
#pragma unroll
      for (int i = 0; i < 4; ++i) ss += a2[ft][i] * a2[ft][i];
    ss += shx(ss, 16); ss += shx(ss, 32);
    const float rinv = rsqrtf(ss * (1.f / 64.f) + 1e-6f);
#pragma unroll
    for (int ft = 0; ft < 4; ++ft) {
      const float4 g4 = *(const float4*)(P.g_k_cmp + 16 * ft + 4 * lg);
      a2[ft][0] *= rinv * g4.x; a2[ft][1] *= rinv * g4.y; a2[ft][2] *= rinv * g4.z; a2[ft][3] *= rinv * g4.w;
    }
    const float* rt = (const float*)(ws + OFF_ROPE) + ((size_t)b * SEQ + 16 * nc + 31) * 16 + 4 * (lg & 1);
    const float4 c4 = *(const float4*)rt, s4 = *(const float4*)(rt + 8);
    const float cs[4] = {c4.x, c4.y, c4.z, c4.w}, sn[4] = {s4.x, s4.y, s4.z, s4.w};
#pragma unroll
    for (int i = 0; i < 4; ++i) {
      const float own = a2[0][i];
      const float oth = shx(own, 32);
      a2[0][i] = (lg < 2) ? (own * cs[i] - oth * sn[i]) : (oth * sn[i] + own * cs[i]);
    }
    bf16_t* dst = (bf16_t*)(ws + OFF_KC) + ((size_t)bg * NCP + n) * 64 + 4 * lg;
    const float z = (n < 511) ? 1.f : 0.f;
#pragma unroll
    for (int ft = 0; ft < 4; ++ft) st4bf(dst + 16 * ft, a2[ft][0] * z, a2[ft][1] * z, a2[ft][2] * z, a2[ft][3] * z);
  } else {
    bf16_t* dst = (bf16_t*)(ws + OFF_VCT) + (size_t)bg * 64 * NCP + (n & ~31) + (((n & 15) >> 2) * 8 + ((n >> 4) & 1) * 4 + (n & 3));
    const float z = (n < 511) ? 1.f : 0.f;
#pragma unroll
    for (int ft = 0; ft < 4; ++ft)
#pragma unroll
      for (int i = 0; i < 4; ++i) dst[(size_t)(16 * ft + 4 * lg + i) * NCP] = f2bf(a2[ft][i] * z);
  }
}

enum { M_WIN = 0, M_SEL = 1, M_MEM = 2, M_CMPA = 3, M_CMPB = 4 };
constexpr int SM_IMP = 49152;
constexpr int SM_OACC = SM_IMP;
constexpr int SM_SEL = SM_OACC + 256 * 68 * 4;
constexpr int SM_MASK = SM_SEL + 1024;
constexpr int SM_LIST = SM_MASK + 1024;
constexpr int SM_LACC = SM_LIST + 8192;
constexpr int SM_QS = SM_LACC + 1024;
constexpr int SM_TOTAL = SM_QS + 32768;

template <int MODE>
DI void attn_run(const bf16_t* __restrict__ kbase, const bf16_t* __restrict__ vbase, const int vstride,
                 const int tile_begin, const int tile_end,
                 const bf16x8 (&qf)[2][2], const int (&tq)[2], const int (&tokl)[2],
                 f32x4 (&o)[2][4], float (&m)[2], float (&l)[2], unsigned char* smem, const int tmin, const float negM,
                 uint4& rk0, uint4& rv0, const bool pre  ,
                 const bf16_t* __restrict__ nk, const bf16_t* __restrict__ nv, const int nvs, const int nt  ,
                 const int ovr = -1  ) {
  if (tile_begin >= tile_end) return;
  const int tid = otid(), lane = tid & 63, l15 = lane & 15, lg = lane >> 4;
  const int srow = tid >> 3, sc = tid & 7;
  const unsigned short* selbits = (const unsigned short*)(smem + SM_SEL);
  float* imp = (float*)(smem + SM_IMP);
#define GL_(rk, rv, t) { rk = *(const uint4*)(kbase + ((size_t)((t) * 64 + srow)) * 64 + sc * 8); \
      if (MODE != M_CMPA) rv = *(const uint4*)(vbase + (size_t)srow * vstride + (t) * 64 + sc * 8); }
#define SW_(rk, rv, buf) { unsigned char* d_ = smem + (buf) * 9216 + srow * 128 + ((sc ^ (srow & 7)) << 4); *(uint4*)(d_) = rk; \
      if (MODE != M_CMPA) *(uint4*)(d_ + 18432) = rv; }
  f32x4 lacc[2] = {(f32x4){0.f, 0.f, 0.f, 0.f}, (f32x4){0.f, 0.f, 0.f, 0.f}};
  const bf16x8 ones = {(short)0x3F80, (short)0x3F80, (short)0x3F80, (short)0x3F80, (short)0x3F80, (short)0x3F80, (short)0x3F80, (short)0x3F80};
  auto compute = [&](const int t, const int buf) __attribute__((always_inline)) {
    const int xsw = ((lg ^ (l15 & 7)) << 4);
    const unsigned char* ck = smem + buf * 9216 + l15 * 128;
    const unsigned char* cv = smem + 18432 + buf * 9216 + l15 * 128;
    bool bit[2] = {true, true};
    bool need = true;
    if (MODE == M_SEL) {
#pragma unroll
      for (int c = 0; c < 2; ++c) bit[c] = (selbits[tokl[c] * 8 + (t >> 4)] >> (t & 15)) & 1;
      need = __any(bit[0] || bit[1]) != 0;
    }
    if (need) {
      f32x4 s[2][4];
#pragma unroll
      for (int c = 0; c < 2; ++c) {
        float ci = negM;
        if (MODE == M_SEL) ci = bit[c] ? negM : -__builtin_inff();
        const f32x4 cinit = {ci, ci, ci, ci};
#pragma unroll
        for (int kt = 0; kt < 4; ++kt) s[c][kt] = cinit;
      }
      {
        bf16x8 kf[2][4];
#pragma unroll
        for (int ks = 0; ks < 2; ++ks)
#pragma unroll
          for (int kt = 0; kt < 4; ++kt) kf[ks][kt] = ld16(ck + kt * 16 * 128 + (xsw ^ (ks << 6)));
        __builtin_amdgcn_sched_barrier(0);
#pragma unroll
        for (int ks = 0; ks < 2; ++ks)
#pragma unroll
          for (int kt = 0; kt < 4; ++kt) {
            s[0][kt] = mfma16(kf[ks][kt], qf[0][ks], s[0][kt]);
            s[1][kt] = mfma16(kf[ks][kt], qf[1][ks], s[1][kt]);
          }
      }
      bf16x8 vf[2][4];
      if (MODE != M_CMPA) {
#pragma unroll
        for (int ks2 = 0; ks2 < 2; ++ks2)
#pragma unroll
          for (int dt = 0; dt < 4; ++dt) vf[ks2][dt] = ld16(cv + dt * 16 * 128 + (xsw ^ (ks2 << 6)));
      }
      __builtin_amdgcn_sched_barrier(0);
      bool needmask = false;
      if (MODE == M_WIN) needmask = (t * 64 + 63 > tmin) || (t * 64 <= tmin + 7 - 512);
      if (MODE == M_SEL) needmask = (t * 64 + 63 > tmin);
      if (MODE == M_CMPA || MODE == M_CMPB) needmask = (16 * (t * 64 + 63) + 31 > tmin);
      if (needmask) {
        const int key0 = t * 64 + 4 * lg;
#pragma unroll
        for (int c = 0; c < 2; ++c)
#pragma unroll
          for (int kt = 0; kt < 4; ++kt)
#pragma unroll
            for (int i = 0; i < 4; ++i) {
              const int kk = key0 + 16 * kt + i;
              bool ok = true;
              if (MODE == M_WIN) ok = (kk <= tq[c]) && (kk > tq[c] - 512);
              if (MODE == M_SEL) ok = (kk <= tq[c]);
              if (MODE == M_CMPA || MODE == M_CMPB) ok = (16 * kk + 31 <= tq[c]);
              s[c][kt][i] = ok ? s[c][kt][i] : -__builtin_inff();
            }
      }
      bf16x8 pf[2][2];
#pragma unroll
      for (int c = 0; c < 2; ++c) {
#pragma unroll
        for (int kt = 0; kt < 4; ++kt) {
          float p0 = ex2(s[c][kt][0]), p1 = ex2(s[c][kt][1]), p2 = ex2(s[c][kt][2]), p3 = ex2(s[c][kt][3]);
          if (MODE == M_CMPB) { p0 *= l[c]; p1 *= l[c]; p2 *= l[c]; p3 *= l[c]; }
          s[c][kt][0] = p0; s[c][kt][1] = p1; s[c][kt][2] = p2; s[c][kt][3] = p3;
        }
        if (MODE == M_CMPB) {
          const int key0 = t * 64 + 4 * lg;
#pragma unroll
          for (int kt = 0; kt < 4; ++kt) {
            float pa = s[c][kt][0] + s[c][kt][1] + s[c][kt][2] + 0.5f * s[c][kt][3];
            float pb = 0.5f * s[c][kt][3];
            pa += dpp_x1f(pa); pa += dpp_x2f(pa);
            pb += dpp_x1f(pb); pb += dpp_x2f(pb);
            if ((lane & 3) == 0) {
              const int j = (key0 + 16 * kt) >> 2;
              float* ip = imp + tokl[c] * 129 + j;
              ip[0] += pa;
              __builtin_amdgcn_fence(__ATOMIC_RELEASE, "wavefront");
              if (j + 1 < 128) ip[1] += pb;
              __builtin_amdgcn_fence(__ATOMIC_RELEASE, "wavefront");
            }
          }
        }
        pf[c][0] = pack8(s[c][0], s[c][1]);
        pf[c][1] = pack8(s[c][2], s[c][3]);
        if (MODE != M_CMPB) {
          lacc[c] = mfma16(ones, pf[c][0], lacc[c]);
          lacc[c] = mfma16(ones, pf[c][1], lacc[c]);
        }
      }
      if (MODE != M_CMPA) {
#pragma unroll
        for (int ks2 = 0; ks2 < 2; ++ks2)
#pragma unroll
          for (int dt = 0; dt < 4; ++dt) {
            o[0][dt] = mfma16(vf[ks2][dt], pf[0][ks2], o[0][dt]);
            o[1][dt] = mfma16(vf[ks2][dt], pf[1][ks2], o[1][dt]);
          }
      }
    }
  };
  if (!pre) GL_(rk0, rv0, (ovr >= 0 ? ovr : tile_begin));
  SW_(rk0, rv0, 0);
  __syncthreads();
#pragma unroll 1
  for (int t = tile_begin; t < tile_end; ++t) {
    const int buf = (t - tile_begin) & 1;
    const bool more = (t + 1 < tile_end);
    if (more) GL_(rk0, rv0, t + 1)
    else if (nt >= 0) {
      rk0 = *(const uint4*)(nk + ((size_t)(nt * 64 + srow)) * 64 + sc * 8);
      rv0 = *(const uint4*)(nv + (size_t)srow * nvs + nt * 64 + sc * 8);
    }
    compute((t == tile_begin && ovr >= 0) ? ovr : t, buf);
    if (more) SW_(rk0, rv0, buf ^ 1);
    __syncthreads();
  }
#undef GL_
#undef SW_
  if (MODE != M_CMPB) { l[0] += lacc[0][0]; l[1] += lacc[1][0]; }
}

DI void attn_reset(f32x4 (&o)[2][4], float (&m)[2], float (&l)[2]) {
#pragma unroll
  for (int c = 0; c < 2; ++c) {
    m[c] = -__builtin_inff(); l[c] = 0.f;
#pragma unroll
    for (int dt = 0; dt < 4; ++dt) o[c][dt] = (f32x4){0.f, 0.f, 0.f, 0.f};
  }
}
DI void attn_accum(f32x4 (&ot)[2][4], const f32x4 (&o)[2][4], const float (&l)[2], const float (&gate)[2]) {
#pragma unroll
  for (int c = 0; c < 2; ++c) {
    const float f = gate[c] / fmaxf(l[c], 1.17549435e-38f);
#pragma unroll
    for (int dt = 0; dt < 4; ++dt) ot[c][dt] += o[c][dt] * f;
  }
}

DI void topk_select(unsigned char* smem, int cur) {
  const int tid = otid(), lane = tid & 63, tok = tid >> 3, sub = tid & 7;
  const float* imp = (const float*)(smem + SM_IMP);
  unsigned short* selbits = (unsigned short*)(smem + SM_SEL);
  unsigned bits = 0;
  if (cur <= 15) {
#pragma unroll
    for (int q = 0; q < 16; ++q) if (16 * sub + q <= cur) bits |= 1u << q;
  } else {
    unsigned key[16];
#pragma unroll
    for (int q = 0; q < 16; ++q) {
      const int j = 16 * sub + q;
      const bool cand = (j >= 1) && (j <= cur - 2);
      key[q] = cand ? (__float_as_uint(imp[tok * 129 + j]) + 1u) : 0u;
    }
    unsigned T = 0;
    bool done = false;
#pragma unroll 1
    for (int b = 30; b >= 0; --b) {
      const unsigned cnd = T | (1u << b);
      int cnt = 0;
#pragma unroll
      for (int q = 0; q < 16; ++q) cnt += (key[q] >= cnd) ? 1 : 0;
      cnt += dpp_x1(cnt); cnt += dpp_x2(cnt); cnt += dpp_hm(cnt);
      if (!done && cnt >= 13) T = cnd;
      done = done || (cnt == 13);
      if (__all(done)) break;
    }
    int cgt = 0, ceq = 0;
#pragma unroll
    for (int q = 0; q < 16; ++q) { cgt += (key[q] > T) ? 1 : 0; ceq += (key[q] == T) ? 1 : 0; }
    int gt_tot = cgt;
    gt_tot += dpp_x1(gt_tot); gt_tot += dpp_x2(gt_tot); gt_tot += dpp_hm(gt_tot);
    int pre = 0;
#pragma unroll
    for (int k = 0; k < 8; ++k) { const int v = __shfl(ceq, (lane & ~7) | k, 64); if (k < sub) pre += v; }
    const int quota = 13 - gt_tot;
#pragma unroll
    for (int q = 0; q < 16; ++q) {
      if (key[q] > T) bits |= 1u << q;
      else if (key[q] == T && T != 0u) { if (pre < quota) bits |= 1u << q; ++pre; }
    }
    if (sub == 0) bits |= 1u;
    if ((cur >> 4) == sub) bits |= 1u << (cur & 15);
    if (((cur - 1) >> 4) == sub) bits |= 1u << ((cur - 1) & 15);
  }
  selbits[tok * 8 + sub] = (unsigned short)bits;
}


DI void sel_sparse(const bf16_t* __restrict__ kbase, const bf16_t* __restrict__ vbase, const int jend  ,
                   unsigned char* smem, const float negM) {
  const int tid = otid(), lane = tid & 63, w = __builtin_amdgcn_readfirstlane(tid >> 6), l15 = lane & 15, lg = lane >> 4;
  const int srow = tid >> 3, sc = tid & 7;
  const unsigned* mask = (const unsigned*)(smem + SM_MASK);
  const unsigned char* list = smem + SM_LIST;
  float* oacc = (float*)(smem + SM_OACC);
  float* lacc_s = (float*)(smem + SM_LACC);
  const unsigned char* qs = smem + SM_QS;
  const bf16x8 ones = {(short)0x3F80, (short)0x3F80, (short)0x3F80, (short)0x3F80, (short)0x3F80, (short)0x3F80, (short)0x3F80, (short)0x3F80};
  uint4 rkA, rvA, rkB, rvB, rkC, rvC;
#define GLS_(rk, rv, t) { const int t_ = ((t) < jend) ? (t) : (jend - 1); rk = *(const uint4*)(kbase + ((size_t)(t_ * 64 + srow)) * 64 + sc * 8); rv = *(const uint4*)(vbase + (size_t)srow * SEQ + t_ * 64 + sc * 8); }
#define SWS_(rk, rv, u) { unsigned char* d_ = smem + (u) * 8192 + srow * 128 + ((sc ^ (srow & 7)) << 4); *(uint4*)(d_) = rk; *(uint4*)(d_ + 24576) = rv; }
  GLS_(rkA, rvA, 1); GLS_(rkB, rvB, 2); GLS_(rkC, rvC, 3);
  SWS_(rkA, rvA, 0); SWS_(rkB, rvB, 1); SWS_(rkC, rvC, 2);
  GLS_(rkA, rvA, 4); GLS_(rkB, rvB, 5); GLS_(rkC, rvC, 6);
  __syncthreads();
#pragma unroll 1
  for (int jb = 1; jb < jend; jb += 3) {
    const int n0 = __builtin_popcount(mask[2 * jb]) + __builtin_popcount(mask[2 * jb + 1]);
    const int n1 = (jb + 1 < jend) ? __builtin_popcount(mask[2 * jb + 2]) + __builtin_popcount(mask[2 * jb + 3]) : 0;
    const int n2 = (jb + 2 < jend) ? __builtin_popcount(mask[2 * jb + 4]) + __builtin_popcount(mask[2 * jb + 5]) : 0;
    const int c0 = (n0 + 3) >> 2, c1 = (n1 + 3) >> 2, c2 = (n2 + 3) >> 2;
    const int T = __builtin_amdgcn_readfirstlane(c0 + c1 + c2);
#pragma unroll 1
    for (int q0 = 0; q0 < T; q0 += 8) {
      const int q = q0 + w;
      const bool act = q < T;
      int u = 0, ct = q;
      if (ct >= c0) { ct -= c0; u = 1; if (ct >= c1) { ct -= c1; u = 2; } }
      f32x4 oo[4];
      float la0 = 0.f;
      int row = 0;
      bool valid = false;
#pragma unroll
      for (int dt = 0; dt < 4; ++dt) oo[dt] = (f32x4){0.f, 0.f, 0.f, 0.f};
      if (act) {
        const int j = jb + u;
        const int n = (u == 0) ? n0 : (u == 1) ? n1 : n2;
        const int xsw = ((lg ^ (l15 & 7)) << 4);
        const unsigned char* ck = smem + u * 8192 + l15 * 128;
        const unsigned char* cv = smem + 24576 + u * 8192 + l15 * 128;
        bf16x8 kf[2][4], vf[2][4];
#pragma unroll
        for (int ks = 0; ks < 2; ++ks)
#pragma unroll
          for (int kt = 0; kt < 4; ++kt) { kf[ks][kt] = ld16(ck + kt * 16 * 128 + (xsw ^ (ks << 6))); vf[ks][kt] = ld16(cv + kt * 16 * 128 + (xsw ^ (ks << 6))); }
        const int idx = 4 * ct + (l15 >> 2);
        valid = idx < n;
        const int tok = valid ? (int)list[j * 64 + idx] : 0;
        row = tok * 4 + (l15 & 3);
        const unsigned char* qr = qs + row * 128;
        const bf16x8 qa = ld16(qr + ((lg ^ (row & 7)) << 4)), qb = ld16(qr + (((4 + lg) ^ (row & 7)) << 4));
        const float ci = valid ? negM : -__builtin_inff();
        f32x4 sv[4];
#pragma unroll
        for (int kt = 0; kt < 4; ++kt) sv[kt] = (f32x4){ci, ci, ci, ci};
#pragma unroll
        for (int kt = 0; kt < 4; ++kt) { sv[kt] = mfma16(kf[0][kt], qa, sv[kt]); sv[kt] = mfma16(kf[1][kt], qb, sv[kt]); }
#pragma unroll
        for (int kt = 0; kt < 4; ++kt)
#pragma unroll
          for (int i = 0; i < 4; ++i) sv[kt][i] = ex2(sv[kt][i]);
        const bf16x8 pa = pack8(sv[0], sv[1]), pb = pack8(sv[2], sv[3]);
        f32x4 la = (f32x4){0.f, 0.f, 0.f, 0.f};
#pragma unroll
        for (int dt = 0; dt < 4; ++dt) { oo[dt] = mfma16(vf[0][dt], pa, oo[dt]); oo[dt] = mfma16(vf[1][dt], pb, oo[dt]); }
        la = mfma16(ones, pa, la); la = mfma16(ones, pb, la);
        la0 = la[0];
      }
      const bool lastr = (q0 + 8 >= T);
#pragma unroll
      for (int uu = 0; uu < 3; ++uu) {
        if (uu) __syncthreads();
        if (uu == 1 && lastr && jb + 3 < jend) {
          SWS_(rkA, rvA, 0); SWS_(rkB, rvB, 1); SWS_(rkC, rvC, 2);
          GLS_(rkA, rvA, jb + 6); GLS_(rkB, rvB, jb + 7); GLS_(rkC, rvC, jb + 8);
        }
        if (act && valid && u == uu) {
          float* op = oacc + row * 68 + 4 * lg;
          f32x4 cur4[4];
#pragma unroll
          for (int dt = 0; dt < 4; ++dt) cur4[dt] = *(const f32x4*)(op + 16 * dt);
#pragma unroll
          for (int dt = 0; dt < 4; ++dt) *(f32x4*)(op + 16 * dt) = cur4[dt] + oo[dt];
          if (lg == 0) lacc_s[row] += la0;
        }
      }
      if (!lastr) __syncthreads();
    }
    if (T == 0 && jb + 3 < jend) {
      SWS_(rkA, rvA, 0); SWS_(rkB, rvB, 1); SWS_(rkC, rvC, 2);
      GLS_(rkA, rvA, jb + 6); GLS_(rkB, rvB, jb + 7); GLS_(rkC, rvC, jb + 8);
    }
    __syncthreads();
  }
#undef GLS_
#undef SWS_
}

DI void p3_nsa_item(const Params& P, const int bg, const int qt, unsigned char* smem) {
  unsigned char* ws = P.ws;
  const int b = bg >> 1, gi = bg & 1, t0 = qt * 64, cur = qt;
  const int tid = otid(), lane = tid & 63, w = tid >> 6, l15 = lane & 15, lg = lane >> 4;
  int tokl[2], tq[2];
  bf16x8 qf[2][2];
  float gt[3][2];
  const int tmin = __builtin_amdgcn_readfirstlane(t0 + 8 * w);
  const float* shifts = (const float*)(ws + OFF_CNT + 128);
  const int head = 4 * gi + (l15 & 3);
#pragma unroll
  for (int c = 0; c < 2; ++c) {
    tokl[c] = 8 * w + 4 * c + (l15 >> 2);
    tq[c] = t0 + tokl[c];
    const bf16_t* qp = (const bf16_t*)(ws + OFF_QN) + ((size_t)(b * 8 + head) * SEQ + tq[c]) * 64 + 8 * lg;
    qf[c][0] = ld16(qp); qf[c][1] = ld16(qp + 32);
    const float* gp = (const float*)(ws + OFF_GATES) + (size_t)(b * SEQ + tq[c]) * 24 + head * 3;
    gt[0][c] = gp[0]; gt[1][c] = gp[1]; gt[2][c] = gp[2];
  }
  f32x4 ot[2][4], o[2][4];
  float m[2], l[2];
#pragma unroll
  for (int c = 0; c < 2; ++c)
#pragma unroll
    for (int dt = 0; dt < 4; ++dt) ot[c][dt] = (f32x4){0.f, 0.f, 0.f, 0.f};
  float* imp = (float*)(smem + SM_IMP);
  for (int i = tid; i < 64 * 129; i += 512) imp[i] = 0.f;
  const bf16_t* kc = (const bf16_t*)(ws + OFF_KC) + (size_t)bg * NCP * 64;
  const bf16_t* vct = (const bf16_t*)(ws + OFF_VCT) + (size_t)bg * 64 * NCP;
  const int ctiles = (qt >> 4) + 1;
#if EN_CMP
  attn_reset(o, m, l);
  uint4 pk_ = make_uint4(0, 0, 0, 0), pv_ = make_uint4(0, 0, 0, 0);
  attn_run<M_CMPA>(kc, vct, NCP, 0, ctiles, qf, tq, tokl, o, m, l, smem, tmin, shifts[2], pk_, pv_, false, kc, vct, NCP, 0);
#pragma unroll
  for (int c = 0; c < 2; ++c) l[c] = 1.f / fmaxf(l[c], 1.17549435e-38f);
  {
    const bf16_t* ksb_ = (const bf16_t*)(ws + OFF_KS) + (size_t)bg * SEQ * 64;
    const bf16_t* vsb_ = (const bf16_t*)(ws + OFF_VST) + (size_t)bg * 64 * SEQ;
    attn_run<M_CMPB>(kc, vct, NCP, 0, ctiles, qf, tq, tokl, o, m, l, smem, tmin, shifts[2], pk_, pv_, true, ksb_, vsb_, SEQ, (cur <= 29) ? 0 : -1);
  }
#pragma unroll
  for (int c = 0; c < 2; ++c)
#pragma unroll
    for (int dt = 0; dt < 4; ++dt) ot[c][dt] += o[c][dt] * gt[0][c];
#else
  __syncthreads();
#endif
  topk_select(smem, cur);
  __syncthreads();
#if EN_SEL
  {
    const bf16_t* kwb = (const bf16_t*)(ws + OFF_KW) + (size_t)bg * SEQ * 64;
    const bf16_t* vwb = (const bf16_t*)(ws + OFF_VWT) + (size_t)bg * 64 * SEQ;
    const int wt0 = (qt >= 8) ? (qt - 8) : 0;
    const bf16_t* ksb = (const bf16_t*)(ws + OFF_KS) + (size_t)bg * SEQ * 64;
    const bf16_t* vsb = (const bf16_t*)(ws + OFF_VST) + (size_t)bg * 64 * SEQ;
    if (cur <= 29) {
      attn_reset(o, m, l);
      attn_run<M_SEL>(ksb, vsb, SEQ, 0, cur + 1, qf, tq, tokl, o, m, l, smem, tmin, shifts[0], pk_, pv_, true, kwb, vwb, SEQ, wt0);
    } else {
      float* oacc = (float*)(smem + SM_OACC);
      for (int i = tid; i < 256 * 68; i += 512) oacc[i] = 0.f;
      if (tid < 256) { ((float*)(smem + SM_LACC))[tid] = 0.f; ((unsigned*)(smem + SM_MASK))[tid] = 0u; }
#pragma unroll
      for (int c = 0; c < 2; ++c) {
        const int row = tokl[c] * 4 + (l15 & 3);
        unsigned char* qr = smem + SM_QS + row * 128;
        *(bf16x8*)(qr + ((lg ^ (row & 7)) << 4)) = qf[c][0];
        *(bf16x8*)(qr + (((4 + lg) ^ (row & 7)) << 4)) = qf[c][1];
      }
      __syncthreads();
      {
        const int tok = tid >> 3, sub = tid & 7;
        unsigned bits = ((const unsigned short*)(smem + SM_SEL))[tok * 8 + sub];
        unsigned* mk = (unsigned*)(smem + SM_MASK);
        while (bits) {
          const int q = __builtin_ctz(bits); bits &= bits - 1;
          const int j = 16 * sub + q;
          if (j != 0 && j < cur - 1) atomicOr(&mk[2 * j + (tok >> 5)], 1u << (tok & 31));
        }
      }
      __syncthreads();
      if (tid >= 1 && tid < cur - 1) {
        const unsigned* mk = (const unsigned*)(smem + SM_MASK);
        unsigned char* ls = smem + SM_LIST + tid * 64;
        unsigned m0 = mk[2 * tid], m1 = mk[2 * tid + 1];
        int k = 0;
        while (m0) { ls[k++] = (unsigned char)__builtin_ctz(m0); m0 &= m0 - 1; }
        while (m1) { ls[k++] = (unsigned char)(32 + __builtin_ctz(m1)); m1 &= m1 - 1; }
      }
      __syncthreads();
      sel_sparse(ksb, vsb, cur - 1, smem, shifts[0]);
      attn_reset(o, m, l);
      attn_run<M_SEL>(ksb, vsb, SEQ, cur - 2, cur + 1, qf, tq, tokl, o, m, l, smem, tmin, shifts[0], pk_, pv_, false, kwb, vwb, SEQ, wt0, 0);
#pragma unroll
      for (int c = 0; c < 2; ++c) {
        const int row = tokl[c] * 4 + (l15 & 3);
        const float* op = (const float*)(smem + SM_OACC) + row * 68 + 4 * lg;
#pragma unroll
        for (int dt = 0; dt < 4; ++dt)
#pragma unroll
          for (int i = 0; i < 4; ++i) o[c][dt][i] += op[16 * dt + i];
        l[c] += ((const float*)(smem + SM_LACC))[row];
      }
    }
  }
  attn_accum(ot, o, l, gt[1]);
#endif
#if EN_WIN
  attn_reset(o, m, l);
  attn_run<M_WIN>((const bf16_t*)(ws + OFF_KW) + (size_t)bg * SEQ * 64, (const bf16_t*)(ws + OFF_VWT) + (size_t)bg * 64 * SEQ, SEQ,
                  (qt >= 8) ? (qt - 8) : 0, cur + 1, qf, tq, tokl, o, m, l, smem, tmin, shifts[1], pk_, pv_, (EN_SEL != 0), nullptr, nullptr, 0, -1);
  attn_accum(ot, o, l, gt[2]);
#endif
#pragma unroll
  for (int c = 0; c < 2; ++c) {
    const size_t off = (size_t)(b * SEQ + tq[c]) * 1024 + head * 64 + 4 * lg;
    const bf16_t* zp = (const bf16_t*)(ws + OFF_ZS) + off;
    bf16_t* yp = (bf16_t*)(ws + OFF_Y) + off;
#pragma unroll
    for (int dt = 0; dt < 4; ++dt) {
      const uint2 zz = *(const uint2*)(zp + 16 * dt);
      st4bf(yp + 16 * dt, ot[c][dt][0] * bf2f((bf16_t)(zz.x & 0xffff)), ot[c][dt][1] * bf2f((bf16_t)(zz.x >> 16)),
            ot[c][dt][2] * bf2f((bf16_t)(zz.y & 0xffff)), ot[c][dt][3] * bf2f((bf16_t)(zz.y >> 16)));
    }
  }
}

DI void p3_mem_item(const Params& P, const int bh, const int qt, unsigned char* smem) {
  unsigned char* ws = P.ws;
  const int b = bh >> 2, h = bh & 3, t0 = qt * 256;
  const int tid = otid(), lane = tid & 63, w = tid >> 6, l15 = lane & 15, lg = lane >> 4;
  int tokl[2], tq[2];
  bf16x8 qf[2][2];
  const int tmin = 0;
#pragma unroll
  for (int c = 0; c < 2; ++c) {
    tokl[c] = 0;
    tq[c] = t0 + 32 * w + 16 * c + l15;
    const bf16_t* qp = (const bf16_t*)(ws + OFF_QM) + ((size_t)bh * SEQ + tq[c]) * 64 + 8 * lg;
    qf[c][0] = ld16(qp); qf[c][1] = ld16(qp + 32);
  }
  f32x4 o[2][4];
  float m[2], l[2];
  uint4 pk_ = make_uint4(0, 0, 0, 0), pv_ = make_uint4(0, 0, 0, 0);
  attn_reset(o, m, l);
  attn_run<M_MEM>((const bf16_t*)(ws + OFF_MK) + (size_t)bh * MEML * 64, (const bf16_t*)(ws + OFF_MVT) + (size_t)bh * 64 * MEML, MEML,
                  0, 4, qf, tq, tokl, o, m, l, smem, tmin, ((const float*)(ws + OFF_CNT + 128))[3], pk_, pv_, false, nullptr, nullptr, 0, -1);
#pragma unroll
  for (int c = 0; c < 2; ++c) {
    const float f = 1.f / fmaxf(l[c], 1.17549435e-38f);
    const size_t off = (size_t)(b * SEQ + tq[c]) * 1024 + 768 + h * 64 + 4 * lg;
    const bf16_t* zp = (const bf16_t*)(ws + OFF_ZS) + off;
    bf16_t* yp = (bf16_t*)(ws + OFF_Y) + off;
#pragma unroll
    for (int dt = 0; dt < 4; ++dt) {
      const uint2 zz = *(const uint2*)(zp + 16 * dt);
      st4bf(yp + 16 * dt, o[c][dt][0] * f * bf2f((bf16_t)(zz.x & 0xffff)), o[c][dt][1] * f * bf2f((bf16_t)(zz.x >> 16)),
            o[c][dt][2] * f * bf2f((bf16_t)(zz.y & 0xffff)), o[c][dt][3] * f * bf2f((bf16_t)(zz.y >> 16)));
    }
  }
}

DI void p3_pool_item(const Params& P, int item, unsigned char* smem) {
  unsigned char* ws = P.ws;
  const int tok0 = item * 128, s0 = tok0 & (SEQ - 1);
  const int tid = otid(), lane = tid & 63, w = tid >> 6, l15 = lane & 15, lg = lane >> 4;
  const bf16_t* vp = (const bf16_t*)(ws + OFF_VP);
  for (int q = tid; q < 143 * 32; q += 512) {
    const int r = q >> 5, cch = q & 31;
    const int s = s0 - 15 + r;
    uint4 v = make_uint4(0, 0, 0, 0);
    if (s >= 0) v = *(const uint4*)(vp + (size_t)(tok0 - 15 + r) * 256 + cch * 8);
    *(uint4*)(smem + r * 528 + cch * 16) = v;
  }
  __syncthreads();
  const int rown = 15 + 16 * w + l15;
  const int s = s0 + 16 * w + l15;
  const int tok = tok0 + 16 * w + l15;
#pragma unroll
  for (int gp = 0; gp < 4; ++gp) {
    const int win = 2 << gp;
    const float rc = 1.f / (float)((s + 1 < win) ? (s + 1) : win);
    f32x4 acc[4];
#pragma unroll
    for (int i = 0; i < 4; ++i) acc[i] = (f32x4){0.f, 0.f, 0.f, 0.f};
#pragma unroll
    for (int ks = 0; ks < 2; ++ks) {
      const int cb = (gp * 64 + 32 * ks + 8 * lg) * 2;
      float sum[8];
#pragma unroll
      for (int j = 0; j < 8; ++j) sum[j] = 0.f;
      uint4 own = make_uint4(0, 0, 0, 0);
      for (int i = 0; i < win; ++i) {
        const uint4 v = *(const uint4*)(smem + (rown - i) * 528 + cb);
        if (i == 0) own = v;
        sum[0] += bf2f((bf16_t)(v.x & 0xffff)); sum[1] += bf2f((bf16_t)(v.x >> 16));
        sum[2] += bf2f((bf16_t)(v.y & 0xffff)); sum[3] += bf2f((bf16_t)(v.y >> 16));
        sum[4] += bf2f((bf16_t)(v.z & 0xffff)); sum[5] += bf2f((bf16_t)(v.z >> 16));
        sum[6] += bf2f((bf16_t)(v.w & 0xffff)); sum[7] += bf2f((bf16_t)(v.w >> 16));
      }
      uint4 pk;
      pk.x = pack2(sum[0] * rc - bf2f((bf16_t)(own.x & 0xffff)), sum[1] * rc - bf2f((bf16_t)(own.x >> 16)));
      pk.y = pack2(sum[2] * rc - bf2f((bf16_t)(own.y & 0xffff)), sum[3] * rc - bf2f((bf16_t)(own.y >> 16)));
      pk.z = pack2(sum[4] * rc - bf2f((bf16_t)(own.z & 0xffff)), sum[5] * rc - bf2f((bf16_t)(own.z >> 16)));
      pk.w = pack2(sum[6] * rc - bf2f((bf16_t)(own.w & 0xffff)), sum[7] * rc - bf2f((bf16_t)(own.w >> 16)));
      const bf16x8 bq = __builtin_bit_cast(bf16x8, pk);
      const bf16_t* wp = (const bf16_t*)(ws + OFF_WPOOL) + (size_t)gp * 4096 + (size_t)l15 * 64 + 32 * ks + 8 * lg;
#pragma unroll
      for (int mt = 0; mt < 4; ++mt) acc[mt] = mfma16(ld16(wp + mt * 16 * 64), bq, acc[mt]);
    }
    const size_t off = (size_t)tok * 1024 + 512 + gp * 64 + 4 * lg;
    const bf16_t* zp = (const bf16_t*)(ws + OFF_ZS) + off;
    bf16_t* yp = (bf16_t*)(ws + OFF_Y) + off;
#pragma unroll
    for (int mt = 0; mt < 4; ++mt) {
      const float4 ps = *(const float4*)(P.pool_scale + gp * 64 + 16 * mt + 4 * lg);
      const uint2 zz = *(const uint2*)(zp + 16 * mt);
      st4bf(yp + 16 * mt, acc[mt][0] * ps.x * bf2f((bf16_t)(zz.x & 0xffff)), acc[mt][1] * ps.y * bf2f((bf16_t)(zz.x >> 16)),
            acc[mt][2] * ps.z * bf2f((bf16_t)(zz.y & 0xffff)), acc[mt][3] * ps.w * bf2f((bf16_t)(zz.y >> 16)));
    }
  }
  __syncthreads();
}

struct EpiIn {
  static constexpr bool PERM = false, AFTER_DRAIN = false;
  const Params* P;
  __device__ __forceinline__ void operator()(const f32x4 (&acc)[2][2][4][2], const pg8::Unit& u, int wr, int wc, int fr, int fq) const {
    const int ft = u.pn * 4 + wc;
#pragma unroll
    for (int ai = 0; ai < 2; ++ai) {
      f32x4 t[4][4];
#pragma unroll
      for (int mt = 0; mt < 4; ++mt)
#pragma unroll
        for (int m = 0; m < 4; ++m) t[mt][m] = acc[ai][mt >> 1][m][mt & 1];
      inproj_epilogue(*P, t, ft, u.pm * 256 + ai * 128 + wr * 64);
    }
  }
};
struct EpiMemKV {
  static constexpr bool PERM = false, AFTER_DRAIN = false;
  const Params* P;
  __device__ __forceinline__ void operator()(const f32x4 (&acc)[2][2][4][2], const pg8::Unit& u, int wr, int wc, int fr, int fq) const {
    const int ft = u.pn * 4 + wc;
#pragma unroll
    for (int ai = 0; ai < 2; ++ai) {
      f32x4 t[4][4];
#pragma unroll
      for (int mt = 0; mt < 4; ++mt)
#pragma unroll
        for (int m = 0; m < 4; ++m) t[mt][m] = acc[ai][mt >> 1][m][mt & 1];
      memkv_epilogue(*P, t, ft, u.pm * 256 + ai * 128 + wr * 64);
    }
  }
};
struct EpiOut {
  static constexpr bool PERM = false, AFTER_DRAIN = false;
  const float* x; float* out;
  __device__ __forceinline__ void operator()(const f32x4 (&acc)[2][2][4][2], const pg8::Unit& u, int wr, int wc, int fr, int fq) const {
    const int ln = otid() & 63;
    const int row0 = u.pm * 256 + wr * 64 + (ln & 15), col0 = u.pn * 256 + wc * 32 + 4 * (ln >> 4);
#pragma unroll
    for (int ai = 0; ai < 2; ++ai) {
      float4 xv[4][2][2];
#pragma unroll
      for (int m = 0; m < 4; ++m)
#pragma unroll
        for (int bj = 0; bj < 2; ++bj)
#pragma unroll
          for (int n = 0; n < 2; ++n)
            xv[m][bj][n] = ntload4(x + (size_t)(row0 + ai * 128 + m * 16) * DM + col0 + bj * 128 + n * 16);
#pragma unroll
      for (int m = 0; m < 4; ++m)
#pragma unroll
        for (int bj = 0; bj < 2; ++bj)
#pragma unroll
          for (int n = 0; n < 2; ++n) {
            const size_t off = (size_t)(row0 + ai * 128 + m * 16) * DM + col0 + bj * 128 + n * 16;
            float4 r; r.x = xv[m][bj][n].x + acc[ai][bj][m][n][0]; r.y = xv[m][bj][n].y + acc[ai][bj][m][n][1];
            r.z = xv[m][bj][n].z + acc[ai][bj][m][n][2]; r.w = xv[m][bj][n].w + acc[ai][bj][m][n][3];
            ntstore4(out + off, r);
          }
    }
  }
};

__device__ unsigned g_bar[2];
typedef __attribute__((address_space(4))) const Params* KargPtr;
DI const Params& PP(const Params&) { KargPtr p = (KargPtr)__builtin_amdgcn_kernarg_segment_ptr(); asm volatile("" : "+s"(p)); return *(const Params*)p; }
DI void grid_barrier(unsigned* cnt, const unsigned target) {
  asm volatile("s_waitcnt vmcnt(0)" ::: "memory");
  __syncthreads();
  if (threadIdx.x == 0) {
    __builtin_amdgcn_fence(__ATOMIC_RELEASE, "agent");
    __hip_atomic_fetch_add(cnt, 1u, __ATOMIC_RELAXED, __HIP_MEMORY_SCOPE_AGENT);
    while (__hip_atomic_load(cnt, __ATOMIC_RELAXED, __HIP_MEMORY_SCOPE_AGENT) < target) __builtin_amdgcn_s_sleep(2);
    __builtin_amdgcn_fence(__ATOMIC_ACQUIRE, "agent");
  }
  __syncthreads();
}

__global__ void __launch_bounds__(512, 2) fwd_megakernel(Params P) {
  cg::grid_group grid = cg::this_grid();
  __shared__ __attribute__((aligned(16))) unsigned char smem[SM_TOTAL];
  __shared__ int s_item;
  const int tid = threadIdx.x;
  const int nblk = gridDim.x;
  int* counter = (int*)(P.ws + OFF_CNT);
  unsigned* gbar = &g_bar[0];
  if (P.out == nullptr) grid.sync();
  const unsigned nb = gridDim.x;

  if (blockIdx.x == 0 && tid < 16) counter[tid] = 0;
  if (blockIdx.x == 0 && tid >= 64 && tid < 68) {
    const int wch = tid - 64;
    const float* gq = (wch == 3) ? P.g_q_mem : P.g_q_nsa;
    const float* gk = (wch == 0) ? P.g_k_slc : (wch == 1) ? P.g_k_win : (wch == 2) ? P.g_k_cmp : P.g_k_mem;
    float mq = 0.f, mk = 0.f;
    for (int i = 0; i < 64; ++i) { mq = fmaxf(mq, fabsf(gq[i])); mk = fmaxf(mk, fabsf(gk[i])); }
    const float bound = 11.8f * mq * mk;
    ((float*)(P.ws + OFF_CNT + 128))[wch] = -fmaxf(0.f, bound - 64.f);
  }
  {
    constexpr int NTR = P0_NT / 2, NBI = 64, NROWIT = (NTOK + NMEMTOK) / 64;
    for (int it = blockIdx.x; it < NTR + NBI + NROWIT; it += nblk) {
      if (it < NROWIT) { p0_row_norm2(PP(P), it * 64 + (tid >> 6) * 8); }
      else if (it < NROWIT + NTR) p0_transpose_pair(PP(P), it - NROWIT, smem);
      else p0_bias_pair(PP(P), it - NROWIT - NTR, smem);
    }
  }
  grid_barrier(gbar, nb);
  {
    pg8::Gemm g; g.A = (const bf16_t*)(P.ws + OFF_XB); g.Bt = (const bf16_t*)(P.ws + OFF_WTIN); g.M = NTOK; g.N = NFP; g.K = DM;
    pg8::StaticOrder S; S.init(g.M, g.N, nblk, (int)blockIdx.x);
    EpiIn E; E.P = &PP(P);
    pg8::gemm_phase<EpiIn, pg8::StaticOrder, false>((PG8_LAS unsigned char*)smem, g, S, E, nullptr);
  }
  grid_barrier(gbar, 2 * nb);
  if (blockIdx.x < 128 || nblk < 144) {
    for (int it = blockIdx.x; it < 128; it += nblk) p2_compress_item(PP(P), it);
  }
  if (blockIdx.x >= 128 || nblk < 144) {
    pg8::Gemm g2; g2.A = (const bf16_t*)(P.ws + OFF_MH); g2.Bt = (const bf16_t*)(P.ws + OFF_WTMKV); g2.M = NMEMTOK; g2.N = 512; g2.K = DM;
    pg8::StaticOrder S2; S2.init(g2.M, g2.N, nblk, (int)((blockIdx.x + nblk - 128) % nblk));
    EpiMemKV E2; E2.P = &PP(P);
    __syncthreads();
    pg8::gemm_phase<EpiMemKV, pg8::StaticOrder, false>((PG8_LAS unsigned char*)smem, g2, S2, E2, nullptr);
  }
  grid_barrier(gbar, 3 * nb);
  {
    constexpr int NX_NSA = 256, NX_MEM = 128, NX_POOL = 64;
    for (int qi = 0; qi < 8; ++qi) {
      const int xq = (blockIdx.x + qi) & 7;
      for (;;) {
        __syncthreads();
        if (tid == 0) s_item = atomicAdd(counter + xq, 1);
        __syncthreads();
        const int it = s_item;
        if (it >= NX_NSA + NX_MEM + NX_POOL) break;
        if (it < NX_NSA) {
          p3_nsa_item(PP(P), 2 * xq + (it >> 7), 127 - (it & 127), smem);
        } else if (it < NX_NSA + NX_MEM) {
          const int i2 = it - NX_NSA;
          p3_mem_item(PP(P), 4 * xq + (i2 >> 5), i2 & 31, smem);
        } else {
          p3_pool_item(PP(P), xq * NX_POOL + (it - NX_NSA - NX_MEM), smem);
        }
      }
    }
  }
  grid_barrier(gbar, 4 * nb);
  {
    pg8::Gemm g; g.A = (const bf16_t*)(P.ws + OFF_Y); g.Bt = (const bf16_t*)(P.ws + OFF_WTOUT); g.M = NTOK; g.N = DM; g.K = DM;
    pg8::StaticOrder S; S.init(g.M, g.N, nblk, (int)blockIdx.x);
    const Params& P4 = PP(P);
    EpiOut E; E.x = P4.x; E.out = P4.out;
    pg8::gemm_phase<EpiOut, pg8::StaticOrder, false>((PG8_LAS unsigned char*)smem, g, S, E, nullptr);
  }
  if (tid == 0) {
    const unsigned old = __hip_atomic_fetch_add(&g_bar[1], 1u, __ATOMIC_RELAXED, __HIP_MEMORY_SCOPE_AGENT);
    if (old == nb - 1) { __hip_atomic_store(&g_bar[0], 0u, __ATOMIC_RELAXED, __HIP_MEMORY_SCOPE_AGENT); __hip_atomic_store(&g_bar[1], 0u, __ATOMIC_RELAXED, __HIP_MEMORY_SCOPE_AGENT); }
  }
}

extern "C" void kernel_launch(void* const* d_in, const int* in_sizes, int n_in,
                              void* d_out, int out_size, void* d_ws, size_t ws_size,
                              hipStream_t stream) {
  static int grid_blocks = 0;
  if (!grid_blocks) {
    int dev = 0, cus = 0, per_cu = 0;
    (void)hipGetDevice(&dev);
    (void)hipDeviceGetAttribute(&cus, hipDeviceAttributeMultiprocessorCount, dev);
    (void)hipOccupancyMaxActiveBlocksPerMultiprocessor(&per_cu, fwd_megakernel, 512, 0);
    if (per_cu > 1) per_cu = 1;
    if (per_cu < 1) per_cu = 1;
    grid_blocks = cus * per_cu;
  }
  if (ws_size < WS_NEED) { fprintf(stderr, "workspace too small: %zu < %zu\n", ws_size, (size_t)WS_NEED); return; }
  Params p{};
  p.x = (const float*)d_in[0]; p.mem = (const float*)d_in[1]; p.pos = (const int*)d_in[2];
  p.g_norm = (const float*)d_in[3]; p.w_in = (const float*)d_in[4]; p.g_q_nsa = (const float*)d_in[5];
  p.g_k_cmp = (const float*)d_in[6]; p.g_k_slc = (const float*)d_in[7]; p.g_k_win = (const float*)d_in[8];
  p.cmp_pos_k = (const float*)d_in[9]; p.w_cmp_k1 = (const float*)d_in[10]; p.w_cmp_k2 = (const float*)d_in[11];
  p.cmp_pos_v = (const float*)d_in[12]; p.w_cmp_v1 = (const float*)d_in[13]; p.w_cmp_v2 = (const float*)d_in[14];
  p.w_pool = (const float*)d_in[15]; p.pool_scale = (const float*)d_in[16]; p.g_mem = (const float*)d_in[17];
  p.w_mem_kv = (const float*)d_in[18]; p.g_q_mem = (const float*)d_in[19]; p.g_k_mem = (const float*)d_in[20];
  p.w_out = (const float*)d_in[21];
  p.out = (float*)d_out;
  p.ws = (unsigned char*)d_ws;
  void* args[] = {&p};
  hipError_t e = hipLaunchCooperativeKernel((void*)fwd_megakernel, dim3(grid_blocks), dim3(512), args, 0, stream);
  if (e != hipSuccess) fprintf(stderr, "cooperative launch failed: %s (grid %d)\n", hipGetErrorString(e), grid_blocks);
}
```
